# Optimizing an MI355X kernel written in HIP

```python
import math
import jax, jax.numpy as jnp
from jax import lax
import numpy as np

D_MODEL = 1024
BATCH = 4
SEQ = 8192
DEPTH = 1

N_MOD = 6
GLA_HEADS = 4
GLA_DK = D_MODEL // 16
GLA_DV = D_MODEL // 8
GLA_WIDTH = GLA_HEADS * GLA_DV
GLA_LOWRANK = 16
GLA_GATE_NORM = 16.0
GLA_CHUNK = 64
FOX_HEADS = 8
FOX_DH = D_MODEL // 16
FOX_WIDTH = FOX_HEADS * FOX_DH
FOX_QBLOCK = 128
MIX_WIDTH = GLA_WIDTH + FOX_WIDTH
SPLIT_SIZES = (GLA_HEADS * GLA_DK, GLA_HEADS * GLA_DK, GLA_WIDTH, GLA_WIDTH, GLA_LOWRANK,
               FOX_WIDTH, FOX_WIDTH, FOX_WIDTH, FOX_HEADS)
IN_COLS = sum(SPLIT_SIZES)
N_EXPERTS = 32
TOP_K = 4
D_FF = D_MODEL
SWIGLU_ALPHA = 1.702
SWIGLU_LIMIT = 7.0
MOE_BLOCK = 128
EPS = 1e-6

kernel_name = "hymba_gla_fox_moe_sandwich_adaln"


def rmsnorm(x, g):
    xf = x.astype(jnp.float32)
    y = xf * lax.rsqrt(jnp.mean(xf * xf, axis=-1, keepdims=True) + EPS)
    return (y * g.astype(jnp.float32)).astype(x.dtype)


def gla_chunked(q, k, v, log_a):
    B, S, H, K = q.shape
    V = v.shape[-1]
    N = S // GLA_CHUNK
    qc = q.reshape(B, N, GLA_CHUNK, H, K).astype(jnp.float32)
    kc = k.reshape(B, N, GLA_CHUNK, H, K).astype(jnp.float32)
    vc = v.reshape(B, N, GLA_CHUNK, H, V)
    b = jnp.cumsum(log_a.reshape(B, N, GLA_CHUNK, H, K), axis=2)
    b_last = b[:, :, -1:]
    q_t = qc * jnp.exp(b) * (K ** -0.5)
    k_t = kc * jnp.exp(-b)
    k_d = kc * jnp.exp(b_last - b)
    causal = jnp.tril(jnp.ones((GLA_CHUNK, GLA_CHUNK), dtype=bool))
    att = jnp.einsum('bnihk,bnjhk->bnhij', q_t, k_t)
    att = jnp.where(causal, att, 0.0)
    o_intra = jnp.einsum('bnhij,bnjhv->bnihv', att, vc)
    kv = jnp.einsum('bnjhk,bnjhv->bnhkv', k_d, vc)
    decay = jnp.exp(b_last[:, :, 0])

    def step(state, inp):
        dec, kv_n = inp
        return dec[..., None] * state + kv_n, state

    init = jnp.zeros((B, H, K, V), jnp.float32)
    _, s_prev = lax.scan(step, init, (jnp.moveaxis(decay, 1, 0), jnp.moveaxis(kv, 1, 0)))
    s_prev = jnp.moveaxis(s_prev, 0, 1)
    o_inter = jnp.einsum('bnihk,bnhkv->bnihv', q_t, s_prev)
    return (o_intra + o_inter).reshape(B, S, H, V)


def forgetting_attention(q, k, v, log_f):
    B, S, H, D = q.shape
    Ft = jnp.moveaxis(jnp.cumsum(log_f.astype(jnp.float32), axis=1), 1, 2)
    scale = D ** -0.5
    outs = []
    for i in range(S // FOX_QBLOCK):
        lo, hi = i * FOX_QBLOCK, (i + 1) * FOX_QBLOCK
        s = jnp.einsum('bqhd,bkhd->bhqk', q[:, lo:hi], k[:, :hi]).astype(jnp.float32) * scale
        s = s + (Ft[:, :, lo:hi, None] - Ft[:, :, None, :hi])
        mask = jnp.arange(hi)[None, :] <= (lo + jnp.arange(FOX_QBLOCK))[:, None]
        s = jnp.where(mask, s, -jnp.inf)
        p = jax.nn.softmax(s, axis=-1)
        outs.append(jnp.einsum('bhqk,bkhd->bqhd', p.astype(v.dtype), v[:, :hi]))
    return jnp.concatenate(outs, axis=1)


def token_mixer(h, w_in, w_gk2, b_gk, gla_norm_gain, b_f, w_o):
    B, S, _ = h.shape
    proj = h @ w_in
    idx = list(np.cumsum(SPLIT_SIZES)[:-1])
    qg, kg, vg, gg, zg, qf, kf, vf, ff = jnp.split(proj, idx, axis=-1)
    gk = zg @ w_gk2 + b_gk
    log_a = jax.nn.log_sigmoid(gk.astype(jnp.float32)) / GLA_GATE_NORM
    o_gla = gla_chunked(qg.reshape(B, S, GLA_HEADS, GLA_DK),
                        kg.reshape(B, S, GLA_HEADS, GLA_DK),
                        vg.reshape(B, S, GLA_HEADS, GLA_DV),
                        log_a.reshape(B, S, GLA_HEADS, GLA_DK))
    o_gla = rmsnorm(o_gla, gla_norm_gain.reshape(GLA_HEADS, GLA_DV)).reshape(B, S, GLA_WIDTH)
    o_gla = (o_gla * jax.nn.silu(gg)).astype(h.dtype)
    log_f = jax.nn.log_sigmoid((ff + b_f).astype(jnp.float32))
    o_fox = forgetting_attention(qf.reshape(B, S, FOX_HEADS, FOX_DH),
                                 kf.reshape(B, S, FOX_HEADS, FOX_DH),
                                 vf.reshape(B, S, FOX_HEADS, FOX_DH), log_f)
    o_fox = o_fox.reshape(B, S, FOX_WIDTH).astype(h.dtype)
    return jnp.concatenate([o_gla, o_fox], axis=-1) @ w_o


def moe(h2d, w_router, b_router, w_e_in, b_e_in, w_e_out, b_e_out):
    T, D = h2d.shape
    logits = (h2d @ w_router + b_router).astype(jnp.float32)
    top_vals, top_idx = lax.top_k(logits, TOP_K)
    gates = jax.nn.softmax(top_vals, axis=-1)
    TK = T * TOP_K
    e_flat = top_idx.reshape(TK).astype(jnp.int32)
    g_flat = gates.reshape(TK)
    tok_flat = jnp.arange(TK, dtype=jnp.int32) // TOP_K
    order = jnp.argsort(e_flat)
    e_sorted, tok_sorted, g_sorted = e_flat[order], tok_flat[order], g_flat[order]
    counts = jnp.bincount(e_flat, length=N_EXPERTS)
    padded = ((counts + MOE_BLOCK - 1) // MOE_BLOCK) * MOE_BLOCK
    start = jnp.cumsum(counts) - counts
    pend = jnp.cumsum(padded)
    pstart = pend - padded
    dest = pstart[e_sorted] + (jnp.arange(TK, dtype=jnp.int32) - start[e_sorted])
    n_blocks = -(-TK // MOE_BLOCK) + N_EXPERTS
    P = n_blocks * MOE_BLOCK
    slot_tok = jnp.full((P,), T, jnp.int32).at[dest].set(tok_sorted)
    block_expert = jnp.minimum(
        jnp.searchsorted(pend, jnp.arange(n_blocks) * MOE_BLOCK, side='right'), N_EXPERTS - 1)
    h_pad = jnp.concatenate([h2d, jnp.zeros((1, D), h2d.dtype)], axis=0)
    xb = h_pad[slot_tok].reshape(n_blocks, MOE_BLOCK, D)

    def expert_block(args):
        xblk, e = args
        u = xblk @ w_e_in[e] + b_e_in[e]
        glu, lin = u[:, :D_FF], u[:, D_FF:]
        glu = jnp.minimum(glu, SWIGLU_LIMIT)
        lin = jnp.clip(lin, -SWIGLU_LIMIT, SWIGLU_LIMIT)
        a = glu * jax.nn.sigmoid(SWIGLU_ALPHA * glu) * (lin + 1.0)
        return a @ w_e_out[e] + b_e_out[e]

    yb = lax.map(expert_block, (xb, block_expert)).reshape(P, D)
    y_slot = yb[dest] * g_sorted[:, None].astype(yb.dtype)
    return jax.ops.segment_sum(y_slot, tok_sorted, num_segments=T)


def setup_inputs(seed: int = 0) -> dict:
    key = jax.random.key(seed)
    ks = jax.random.split(key, 24)
    f32 = jnp.float32
    n = lambda k, shape, s: jax.random.normal(k, shape, f32) * s
    D = D_MODEL
    return {
        "x": n(ks[0], (BATCH, SEQ, D), 1.0),
        "c": n(ks[1], (BATCH, D), 1.0),
        "w_ada": n(ks[2], (D, N_MOD * D), 0.5 * D ** -0.5),
        "b_ada": n(ks[3], (N_MOD * D,), 0.1),
        "attn_pre_gain": 1.0 + n(ks[4], (D,), 0.02),
        "attn_post_gain": 1.0 + n(ks[5], (D,), 0.02),
        "w_in": n(ks[6], (D, IN_COLS), D ** -0.5),
        "w_gk2": n(ks[7], (GLA_LOWRANK, GLA_HEADS * GLA_DK), GLA_LOWRANK ** -0.5),
        "b_gk": n(ks[8], (GLA_HEADS * GLA_DK,), 0.1),
        "gla_norm_gain": 1.0 + n(ks[9], (GLA_WIDTH,), 0.02),
        "b_f": 3.0 + n(ks[10], (FOX_HEADS,), 0.5),
        "w_o": n(ks[11], (MIX_WIDTH, D), MIX_WIDTH ** -0.5),
        "mlp_pre_gain": 1.0 + n(ks[12], (D,), 0.02),
        "mlp_post_gain": 1.0 + n(ks[13], (D,), 0.02),
        "w_router": n(ks[14], (D, N_EXPERTS), D ** -0.5),
        "b_router": n(ks[15], (N_EXPERTS,), 0.01),
        "w_e_in": n(ks[16], (N_EXPERTS, D, 2 * D_FF), D ** -0.5),
        "b_e_in": n(ks[17], (N_EXPERTS, 2 * D_FF), 0.01),
        "w_e_out": n(ks[18], (N_EXPERTS, D_FF, D), D_FF ** -0.5),
        "b_e_out": n(ks[19], (N_EXPERTS, D), 0.01),
    }


def reference(x, c, w_ada, b_ada, attn_pre_gain, attn_post_gain, w_in, w_gk2, b_gk,
              gla_norm_gain, b_f, w_o, mlp_pre_gain, mlp_post_gain, w_router, b_router,
              w_e_in, b_e_in, w_e_out, b_e_out):
    B, S, D = x.shape
    mod = jax.nn.silu(c) @ w_ada + b_ada
    shift_a, scale_a, gate_a, shift_m, scale_m, gate_m = [m[:, None, :] for m in jnp.split(mod, N_MOD, axis=-1)]
    for _ in range(DEPTH):
        h = rmsnorm(x, attn_pre_gain) * (1.0 + scale_a) + shift_a
        y = token_mixer(h, w_in, w_gk2, b_gk, gla_norm_gain, b_f, w_o)
        x = x + gate_a * rmsnorm(y, attn_post_gain)
        h = rmsnorm(x, mlp_pre_gain) * (1.0 + scale_m) + shift_m
        y = moe(h.reshape(B * S, D), w_router, b_router, w_e_in, b_e_in, w_e_out, b_e_out).reshape(B, S, D)
        x = x + gate_m * rmsnorm(y, mlp_post_gain)
    return x
```

```cpp
#include <hip/hip_runtime.h>
#include <cstdio>
#include <cstdint>

typedef unsigned short bf16_t;
constexpr int NB = 4, S = 8192, D = 1024, M = NB * S;
constexpr int NPROJ = 3072;
constexpr int PC_QF = 0, PC_KF = 512, PC_VF = 1024, PC_QG = 1536, PC_KG = 1792, PC_VG = 2048, PC_GG = 2560;
constexpr int NE = 32, TOPK = 4, TK = M * TOPK;
constexpr int MAXTILES = 544, PMAX = MAXTILES * 256;
constexpr float EPS = 1e-6f;
constexpr float LOG2E = 1.4426950408889634f;
constexpr float C2 = 0.125f * LOG2E;
constexpr float WSCALE = 32.f, WSCALE_INV = 1.f / 32.f;

constexpr size_t MiB = 1u << 20;
constexpr size_t WS_CTL = 0;
constexpr size_t WS_MOD = 1 * MiB;
constexpr size_t WS_ZF = 2 * MiB;
constexpr size_t WS_NF = 6 * MiB;
constexpr size_t WS_TOPE = 7 * MiB;
constexpr size_t WS_TOPG = 8 * MiB;
constexpr size_t WS_RANK = 9 * MiB;
constexpr size_t WS_TPOS = 10 * MiB;
constexpr size_t WS_SLOT = 11 * MiB;
constexpr size_t WS_XN = 12 * MiB;
constexpr size_t WS_BIG = 80 * MiB;
constexpr size_t WS_PROJ = WS_BIG;
constexpr size_t WS_AO = WS_PROJ + 208 * MiB;
constexpr size_t WS_Y = WS_AO + 64 * MiB;
constexpr size_t WS_ACT = WS_BIG;
constexpr size_t WS_YS = WS_Y + 128 * MiB;
constexpr size_t WS_END = WS_YS + 272 * MiB;
constexpr size_t WS_X1B = WS_BIG + 140 * MiB;
static_assert(WS_ACT + (size_t)PMAX * 1024 * 2 <= WS_Y, "ACT overlay");
constexpr int CW_CNT = 0;
constexpr int CW_PLAN = 64;
constexpr int CW_TILEE = 128;
constexpr int CW_AQ = 960;
constexpr int CW_QK2 = 1024;

__device__ __forceinline__ float bf2f(unsigned v) { return __uint_as_float(v << 16); }
typedef float hw_f32x2 __attribute__((ext_vector_type(2))); typedef __bf16 hw_bf16x2 __attribute__((ext_vector_type(2)));
__device__ __forceinline__ unsigned pk2(float lo, float hi) { const hw_f32x2 v = {lo, hi}; return __builtin_bit_cast(unsigned, __builtin_convertvector(v, hw_bf16x2)); }
__device__ __forceinline__ unsigned f2bf(float f) { return pk2(f, f) & 0xffffu; }
__device__ __forceinline__ unsigned pk4_fp8(float a, float b, float c, float d) { int v = __builtin_amdgcn_cvt_pk_fp8_f32(a, b, 0, false); v = __builtin_amdgcn_cvt_pk_fp8_f32(c, d, v, true); return (unsigned)v; }
typedef float fp8x2_f32 __attribute__((ext_vector_type(2)));
template <int CTRL> __device__ __forceinline__ float dpp_mov_f(float x) { return __builtin_bit_cast(float, __builtin_amdgcn_update_dpp(0, __builtin_bit_cast(int, x), CTRL, 0xF, 0xF, true)); }
template <int CTRL> __device__ __forceinline__ int dpp_mov_i(int x) { return __builtin_amdgcn_update_dpp(0, x, CTRL, 0xF, 0xF, true); }
__device__ __forceinline__ float row16_sum(float v) { v += dpp_mov_f<0xB1>(v); v += dpp_mov_f<0x4E>(v); v += dpp_mov_f<0x141>(v); v += dpp_mov_f<0x140>(v); return v; }
__device__ __forceinline__ float wave_sum(float v) {
    v = row16_sum(v);
    const int b = __builtin_bit_cast(int, v);
    return (__builtin_bit_cast(float, __builtin_amdgcn_readlane(b, 0)) + __builtin_bit_cast(float, __builtin_amdgcn_readlane(b, 16))) + (__builtin_bit_cast(float, __builtin_amdgcn_readlane(b, 32)) + __builtin_bit_cast(float, __builtin_amdgcn_readlane(b, 48)));
}
#define ARGMAX_DPP(CTRL, bv, bi) do { const float ov_ = dpp_mov_f<CTRL>(bv); const int oi_ = dpp_mov_i<CTRL>(bi); if (ov_ > bv || (ov_ == bv && oi_ < bi)) { bv = ov_; bi = oi_; } } while (0)
__device__ __forceinline__ float silu_f(float x) { return x / (1.f + __expf(-x)); }
__device__ __forceinline__ float logsigmoid_f(float x) { return fminf(x, 0.f) - log1pf(__expf(-fabsf(x))); }


namespace pg8 {
#define PG8_LAS __attribute__((address_space(3)))
typedef short bf16x8 __attribute__((ext_vector_type(8)));
typedef float f32x4 __attribute__((ext_vector_type(4)));
typedef unsigned u32x4 __attribute__((ext_vector_type(4)));
typedef int i32x4 __attribute__((ext_vector_type(4)));
typedef int i32x8 __attribute__((ext_vector_type(8)));
typedef unsigned u32x2 __attribute__((ext_vector_type(2)));
constexpr int BM = 256, BK = 64, HALF = 128, HTB = HALF * BK * 2, STAGE_BYTES = 8 * HTB, NXCD = 8, WGM = 4;

__host__ __device__ __forceinline__ int lds_byte(int r, int c) { const int st = (r >> 4) * 2 + (c >> 5), rr = r & 15, cc = c & 31, ob = rr * 64 + cc * 2; return st * 1024 + (ob ^ (((ob >> 9) & 1) << 5)); }
__host__ __device__ __forceinline__ void stage_rc(int b, int& R, int& C) { const int st = b / 1024, sb = b % 1024, swz = sb ^ (((sb >> 9) & 1) << 5); R = (st >> 1) * 16 + swz / 64; C = (st & 1) * 32 + (swz % 64) / 2; }
__host__ __device__ __forceinline__ int perm32(int rho) { const int n = rho >> 4, i = rho & 15; return 8 * (i >> 2) + 4 * n + (i & 3); }

struct Unit { int pm, pn, e; };
struct Gemm { const void* A; const void* Bt; int K; size_t estride; const int* rowidx; const PG8_LAS int* tb; const PG8_LAS int* cn; };

struct Order {
    int nM, nN, nwg, G, c; const PG8_LAS int* tile_e;
    __device__ void init(int nM_, int nN_, int G_, int c_, const PG8_LAS int* te) { nM = nM_; nN = nN_; nwg = nM * nN; G = G_; c = c_; tile_e = te; }
    __device__ bool next(int i, Unit& u) const {
        const long L = (long)i * G + c; if (L >= nwg) return false;
        int wgid = (int)L; { const int q = nwg / NXCD, r = nwg % NXCD, xcd = wgid % NXCD, off = wgid / NXCD; wgid = (xcd < r ? xcd * (q + 1) : r * (q + 1) + (xcd - r) * q) + off; }
        const int nig = WGM * nN, gid = wgid / nig, fm = gid * WGM, gsz = (nM - fm) < WGM ? (nM - fm) : WGM;
        u.pm = fm + ((wgid % nig) % gsz); u.pn = (wgid % nig) / gsz;
        u.e = tile_e ? __builtin_amdgcn_readfirstlane(tile_e[u.pm]) : 0;
        return true;
    }
};

__device__ __forceinline__ unsigned cvt_pk_bf16(float lo, float hi) { unsigned r; asm volatile("v_cvt_pk_bf16_f32 %0, %1, %2" : "=v"(r) : "v"(lo), "v"(hi)); return r; }

struct EpiProj {
    static constexpr bool PERM = true;
    bf16_t* P; float* ZF;
    __device__ __forceinline__ void operator()(const f32x4 (&acc)[2][2][4][2], const Unit& u, int wr, int wc, int fr, int fq) const {
        const int row0 = u.pm * BM + wr * 64 + fr;
        {
            const int col0 = u.pn * BM + wc * 32 + 8 * fq; const float sc = u.pn < 2 ? C2 : 1.f;
#pragma unroll
            for (int ai = 0; ai < 2; ++ai)
#pragma unroll
                for (int m = 0; m < 4; ++m) { bf16_t* rowp = P + (size_t)(row0 + ai * HALF + m * 16) * NPROJ + col0;
#pragma unroll
                    for (int bj = 0; bj < 2; ++bj) { const f32x4 v0 = acc[ai][bj][m][0] * sc, v1 = acc[ai][bj][m][1] * sc; u32x4 w;
                        w.x = cvt_pk_bf16(v0[0], v0[1]); w.y = cvt_pk_bf16(v0[2], v0[3]); w.z = cvt_pk_bf16(v1[0], v1[1]); w.w = cvt_pk_bf16(v1[2], v1[3]);
                        *(u32x4*)(rowp + bj * HALF) = w; } }
        }
    }
};
struct EpiBf16 {
    static constexpr bool PERM = true;
    bf16_t* C; int ldc;
    __device__ __forceinline__ void operator()(const f32x4 (&acc)[2][2][4][2], const Unit& u, int wr, int wc, int fr, int fq) const {
        const int row0 = u.pm * BM + wr * 64 + fr, col0 = u.pn * BM + wc * 32 + 8 * fq;
#pragma unroll
        for (int ai = 0; ai < 2; ++ai)
#pragma unroll
            for (int m = 0; m < 4; ++m) { bf16_t* rowp = C + (size_t)(row0 + ai * HALF + m * 16) * ldc + col0;
#pragma unroll
                for (int bj = 0; bj < 2; ++bj) { const f32x4 v0 = acc[ai][bj][m][0], v1 = acc[ai][bj][m][1]; u32x4 w;
                    w.x = cvt_pk_bf16(v0[0], v0[1]); w.y = cvt_pk_bf16(v0[2], v0[3]); w.z = cvt_pk_bf16(v1[0], v1[1]); w.w = cvt_pk_bf16(v1[2], v1[3]);
                    *(u32x4*)(rowp + bj * HALF) = w; } }
    }
};
struct EpiE1 {
    static constexpr bool PERM = true;
    unsigned char* ACT; const float* b_in;
    __device__ __forceinline__ void operator()(const f32x4 (&acc)[2][2][4][2], const Unit& u, int wr, int wc, int fr, int fq) const {
        const int row0 = u.pm * BM + wr * 64 + fr, col0 = u.pn * HALF + wc * 32 + 8 * fq;
        const float* bg = b_in + (size_t)u.e * 2048 + col0;
        const f32x4 bg0 = *(const f32x4*)(bg), bg1 = *(const f32x4*)(bg + 4), bl0 = *(const f32x4*)(bg + 1024) + 1.f, bl1 = *(const f32x4*)(bg + 1028) + 1.f;
#pragma unroll
        for (int ai = 0; ai < 2; ++ai)
#pragma unroll
            for (int m = 0; m < 4; ++m) { float o[8];
#pragma unroll
                for (int n = 0; n < 2; ++n) { const f32x4 g4 = acc[ai][0][m][n] * WSCALE_INV + (n ? bg1 : bg0), l4 = acc[ai][1][m][n] * WSCALE_INV + (n ? bl1 : bl0);
#pragma unroll
                    for (int i = 0; i < 4; ++i) { const float glu = fminf(g4[i], 7.f), lin1 = __builtin_amdgcn_fmed3f(l4[i], -6.f, 8.f);
                        const float sg = __builtin_amdgcn_rcpf(1.f + __builtin_amdgcn_exp2f(-1.702f * LOG2E * glu));
                        o[n * 4 + i] = glu * sg * lin1; } }
                u32x2 w; w.x = pk4_fp8(o[0], o[1], o[2], o[3]); w.y = pk4_fp8(o[4], o[5], o[6], o[7]);
                *(u32x2*)(ACT + (size_t)(row0 + ai * HALF + m * 16) * 1024 + col0) = w; }
    }
};
struct EpiE2 {
    static constexpr bool PERM = true;
    unsigned char* YS; const float* b_out;
    __device__ __forceinline__ void operator()(const f32x4 (&acc)[2][2][4][2], const Unit& u, int wr, int wc, int fr, int fq) const {
        const int row0 = u.pm * BM + wr * 64 + fr, col0 = u.pn * BM + wc * 32 + 8 * fq;
        const float* bp = b_out + (size_t)u.e * 1024 + col0;
#pragma unroll
        for (int bj = 0; bj < 2; ++bj) { const f32x4 b0 = *(const f32x4*)(bp + bj * HALF), b1 = *(const f32x4*)(bp + bj * HALF + 4);
#pragma unroll
            for (int ai = 0; ai < 2; ++ai)
#pragma unroll
                for (int m = 0; m < 4; ++m) { const f32x4 v0 = acc[ai][bj][m][0] * WSCALE_INV + b0, v1 = acc[ai][bj][m][1] * WSCALE_INV + b1; u32x2 w;
                    w.x = pk4_fp8(__builtin_amdgcn_fmed3f(v0[0], -448.f, 448.f), __builtin_amdgcn_fmed3f(v0[1], -448.f, 448.f), __builtin_amdgcn_fmed3f(v0[2], -448.f, 448.f), __builtin_amdgcn_fmed3f(v0[3], -448.f, 448.f));
                    w.y = pk4_fp8(__builtin_amdgcn_fmed3f(v1[0], -448.f, 448.f), __builtin_amdgcn_fmed3f(v1[1], -448.f, 448.f), __builtin_amdgcn_fmed3f(v1[2], -448.f, 448.f), __builtin_amdgcn_fmed3f(v1[3], -448.f, 448.f));
                    *(u32x2*)(YS + (size_t)(row0 + ai * HALF + m * 16) * 1024 + col0 + bj * HALF) = w; } }
    }
};

template <class Epi, int AMODE, bool FP8>
__device__ __forceinline__ void gemm_phase(PG8_LAS unsigned char* lds, const Gemm g, const Order& S, const Epi& E) {
    const int tid = threadIdx.x, wid = __builtin_amdgcn_readfirstlane(tid >> 6), lane = tid & 63, wr = wid >> 2, wc = wid & 3, fr = lane & 15, fq = lane >> 4;
    const int K = g.K, KB = FP8 ? K : 2 * K  , nt = KB / 128;
    int Rr[2], Cc[2]; unsigned voffB[2], voffA[2];
#pragma unroll
    for (int i = 0; i < 2; ++i) { int R, C; stage_rc(tid * 16 + i * 8192, R, C); const int Rb = Epi::PERM ? ((R & ~31) + perm32(R & 31)) : R;
        Rr[i] = R; Cc[i] = C; voffB[i] = (unsigned)(Rb * KB + C * 2); voffA[i] = (unsigned)(R * KB + C * 2); }
    const size_t kstep = (size_t)(BK * 2);
    const size_t hstep = (size_t)HALF * KB;
    const size_t tstep = 2 * hstep;
    const unsigned ldsw = (unsigned)wid * 1024u;
    const int aoff = lds_byte(wr * 64 + fr, fq * 8), boff = lds_byte(wc * 32 + fr, fq * 8);
    const char* Abase = (const char*)g.A;
#define PG8_SA(b, h) (((b) * 2 + (h)) * HTB)
#define PG8_SB(b, h) ((4 + (b) * 2 + (h)) * HTB)
#define PG8_STAGE_B(bufoff, gbase) do { _Pragma("unroll") for (int _i = 0; _i < 2; ++_i) \
        __builtin_amdgcn_global_load_lds((const unsigned*)((const char*)(gbase) + voffB[_i]), (PG8_LAS unsigned*)(lds + (bufoff) + ldsw + _i * 8192), 16, 0, 0); } while (0)
#define PG8_STAGE_A(bufoff, UB, h, kb) do { _Pragma("unroll") for (int _i = 0; _i < 2; ++_i) { \
        const char* _src = AMODE != 0 ? Abase + (size_t)co[h][_i] + (size_t)(kb) : (UB) + (size_t)(h) * hstep + (size_t)(kb) + voffA[_i]; \
        __builtin_amdgcn_global_load_lds((const unsigned*)_src, (PG8_LAS unsigned*)(lds + (bufoff) + ldsw + _i * 8192), 16, 0, 0); } } while (0)
#define PG8_AOFFS(u, OFF) do { int _tb0 = 0, _cn0 = 0; if (AMODE == 1) { _tb0 = __builtin_amdgcn_readfirstlane(g.tb[(u).e]); _cn0 = __builtin_amdgcn_readfirstlane(g.cn[(u).e]); } \
        _Pragma("unroll") for (int _h = 0; _h < 2; ++_h) _Pragma("unroll") for (int _i = 0; _i < 2; ++_i) { \
        int _row = (u).pm * BM + _h * HALF + Rr[_i]; \
        if (AMODE == 1) { const int _loc = _row - _tb0 * BM; const int _rv = g.rowidx[(u).e * M + (_loc < _cn0 ? _loc : 0)]; _row = _loc < _cn0 ? _rv : M; }     \
        (OFF)[_h][_i] = (unsigned)(_row * KB + Cc[_i] * 2); } } while (0)
#define PG8_LD8(p) __builtin_shufflevector(*(const PG8_LAS i32x4*)(p), *(const PG8_LAS i32x4*)((p) + 1024), 0, 1, 2, 3, 4, 5, 6, 7)
#define PG8_LDA(dst, b, h) do { if constexpr (FP8) { _Pragma("unroll") for (int m = 0; m < 4; ++m) dst##8[m] = PG8_LD8(lds + PG8_SA(b, h) + aoff + m * 2048); } else { \
        _Pragma("unroll") for (int m = 0; m < 4; ++m) _Pragma("unroll") for (int k = 0; k < 2; ++k) dst[m][k] = *(const PG8_LAS bf16x8*)(lds + PG8_SA(b, h) + aoff + m * 2048 + k * 1024); } } while (0)
#define PG8_LDB(dst, b, h) do { if constexpr (FP8) { _Pragma("unroll") for (int n = 0; n < 2; ++n) dst##8[n] = PG8_LD8(lds + PG8_SB(b, h) + boff + n * 2048); } else { \
        _Pragma("unroll") for (int n = 0; n < 2; ++n) _Pragma("unroll") for (int k = 0; k < 2; ++k) dst[n][k] = *(const PG8_LAS bf16x8*)(lds + PG8_SB(b, h) + boff + n * 2048 + k * 1024); } } while (0)
#define MMA(ai, bj, At, Bt) do { __builtin_amdgcn_s_setprio(1); if constexpr (FP8) { _Pragma("unroll") for (int m = 0; m < 4; ++m) _Pragma("unroll") for (int n = 0; n < 2; ++n) \
        acc[ai][bj][m][n] = __builtin_amdgcn_mfma_scale_f32_16x16x128_f8f6f4(Bt##8[n], At##8[m], acc[ai][bj][m][n], 0, 0, 0, 0, 0, 0); } else { \
        _Pragma("unroll") for (int m = 0; m < 4; ++m) _Pragma("unroll") for (int n = 0; n < 2; ++n) _Pragma("unroll") for (int k = 0; k < 2; ++k) \
        acc[ai][bj][m][n] = __builtin_amdgcn_mfma_f32_16x16x32_bf16(Bt[n][k], At[m][k], acc[ai][bj][m][n], 0, 0, 0); } __builtin_amdgcn_s_setprio(0); } while (0)
#define PG8_WAIT_V(n) asm volatile("s_waitcnt vmcnt(" #n ")" ::: "memory")
#define PG8_WAIT_L(n) asm volatile("s_waitcnt lgkmcnt(" #n ")" ::: "memory")
#define PG8_BAR __builtin_amdgcn_s_barrier()
#define PG8_SCHED __builtin_amdgcn_sched_barrier(0)
    Unit cur, nxt; int ui = 0;
    if (!S.next(0, cur)) return;
    unsigned co[2][2];
    if constexpr (AMODE != 0) PG8_AOFFS(cur, co);
    const char* cA = Abase + (size_t)cur.pm * tstep;
    f32x4 acc[2][2][4][2];
#pragma unroll
    for (int a = 0; a < 2; ++a)
#pragma unroll
        for (int b = 0; b < 2; ++b)
#pragma unroll
            for (int m = 0; m < 4; ++m)
#pragma unroll
                for (int n = 0; n < 2; ++n) { acc[a][b][m][n] = (f32x4){0.f, 0.f, 0.f, 0.f}; asm volatile("" : "+v"(acc[a][b][m][n])); }
    bf16x8 At[4][2], B0[2][2], B1[2][2]; i32x8 At8[4], B08[2], B18[2];
    const char* cB = (const char*)g.Bt + ((size_t)cur.e * g.estride) * (FP8 ? 1 : 2) + (size_t)cur.pn * tstep;
#define PG8_KO(j, r) ((size_t)(((j) + (r)) & (nt - 1)) * kstep)
    int rc = (cur.pm + cur.pn) & (nt - 1);
    PG8_STAGE_B(PG8_SB(0, 0), cB + PG8_KO(0, rc)); PG8_STAGE_B(PG8_SB(0, 1), cB + hstep + PG8_KO(0, rc)); PG8_STAGE_A(PG8_SA(0, 0), cA, 0, PG8_KO(0, rc)); PG8_STAGE_A(PG8_SA(0, 1), cA, 1, PG8_KO(0, rc));
    if (wr == 1) PG8_BAR;
    PG8_WAIT_V(2); PG8_BAR;
    PG8_STAGE_B(PG8_SB(1, 0), cB + PG8_KO(1, rc)); PG8_STAGE_A(PG8_SA(1, 0), cA, 0, PG8_KO(1, rc)); PG8_STAGE_B(PG8_SB(1, 1), cB + hstep + PG8_KO(1, rc));
    PG8_WAIT_V(6); PG8_BAR;
    for (;;) {
        const bool has_next = S.next(ui + 1, nxt);
        const char* nB = cB; const char* nA = cA; int rn = rc;
        if (has_next) { rn = (nxt.pm + nxt.pn) & (nt - 1); nA = Abase + (size_t)nxt.pm * tstep; nB = (const char*)g.Bt + ((size_t)nxt.e * g.estride) * (FP8 ? 1 : 2) + (size_t)nxt.pn * tstep; }
#pragma unroll 1
        for (int t = 0; t < nt; t += 2) {
            const bool last = (t == nt - 2);
            const size_t kb1 = PG8_KO(t + 1, rc);
            const char* a2 = last ? nA : cA;
            const size_t kb2 = last ? PG8_KO(0, rn) : PG8_KO(t + 2, rc), kb3 = last ? PG8_KO(1, rn) : PG8_KO(t + 3, rc);
            const char* b2 = (last ? nB : cB) + kb2; const char* b3 = (last ? nB : cB) + kb3;
            PG8_LDB(B0, 0, 0); PG8_LDB(B1, 0, 1); PG8_SCHED; PG8_LDA(At, 0, 0); PG8_STAGE_A(PG8_SA(1, 1), cA, 1, kb1);
            if constexpr (AMODE != 0) { if (last && has_next) PG8_AOFFS(nxt, co); }
            PG8_WAIT_V(8); PG8_WAIT_L(0); PG8_BAR; MMA(0, 0, At, B0); MMA(0, 1, At, B1); PG8_BAR; PG8_SCHED;
            PG8_LDA(At, 0, 1); PG8_STAGE_B(PG8_SB(0, 0), b2); PG8_STAGE_B(PG8_SB(0, 1), b2 + hstep); PG8_STAGE_A(PG8_SA(0, 0), a2, 0, kb2);
            PG8_WAIT_V(8); PG8_WAIT_L(0); PG8_BAR; MMA(1, 0, At, B0); MMA(1, 1, At, B1); PG8_BAR; PG8_SCHED;
            PG8_LDB(B0, 1, 0); PG8_LDB(B1, 1, 1); PG8_SCHED; PG8_LDA(At, 1, 0); PG8_STAGE_A(PG8_SA(0, 1), a2, 1, kb2);
            PG8_WAIT_V(8); PG8_WAIT_L(0); PG8_BAR; MMA(0, 0, At, B0); MMA(0, 1, At, B1); PG8_BAR; PG8_SCHED;
            PG8_LDA(At, 1, 1); PG8_STAGE_B(PG8_SB(1, 0), b3); PG8_STAGE_B(PG8_SB(1, 1), b3 + hstep); PG8_STAGE_A(PG8_SA(1, 0), a2, 0, kb3);
            PG8_WAIT_V(8); PG8_WAIT_L(0); PG8_BAR; MMA(1, 0, At, B0); MMA(1, 1, At, B1); PG8_BAR; PG8_SCHED;
        }
        if (wr == 0) PG8_BAR;
        E(acc, cur, wr, wc, fr, fq);
        if (!has_next) break;
#pragma unroll
        for (int a = 0; a < 2; ++a)
#pragma unroll
            for (int b = 0; b < 2; ++b)
#pragma unroll
                for (int m = 0; m < 4; ++m)
#pragma unroll
                    for (int n = 0; n < 2; ++n) { acc[a][b][m][n] = (f32x4){0.f, 0.f, 0.f, 0.f}; asm volatile("" : "+v"(acc[a][b][m][n])); }
        cur = nxt; cB = nB; cA = nA; rc = rn; ++ui;
        if (wr == 1) PG8_BAR;
    }
    PG8_WAIT_V(0);
    PG8_BAR;
#undef PG8_SA
#undef PG8_SB
#undef PG8_STAGE_A
#undef PG8_STAGE_B
#undef PG8_AOFFS
#undef PG8_KO
#undef PG8_LDA
#undef PG8_LDB
#undef MMA
#undef PG8_LD8
#undef PG8_WAIT_V
#undef PG8_WAIT_L
#undef PG8_BAR
#undef PG8_SCHED
}
}

#include <hip/hip_bf16.h>
#include <cmath>
namespace attn_body {
using bf16=__hip_bfloat16;
using bf16x8=__attribute__((ext_vector_type(8)))short;
using s16x4=__attribute__((ext_vector_type(4)))short;
using f32x16=__attribute__((ext_vector_type(16)))float;
using u32x4=__attribute__((ext_vector_type(4)))unsigned;
constexpr int BATCH=4,NHEAD=8,SEQ=8192,D=64,PQ=3072,PO=1024;
constexpr int NW=8,QBLK=32,QB=QBLK*NW,KVBLK=64,NQB=SEQ/QB;
constexpr int ATTN_UNIT_ROWS=QB;
__device__ __forceinline__ int crow(int r,int hi){return (r&3)+8*(r>>2)+4*hi;}
#define SBAR() __builtin_amdgcn_sched_barrier(0)
__device__ __forceinline__ void cmask(f32x16&p0,f32x16&p1,int jb,int qrel,int hi){
  const float NEG=-INFINITY; int kb=64*jb+4*hi;
  #pragma unroll
  for(int r=0;r<16;++r){int kv=kb+(r&3)+8*(r>>2); if(kv>qrel)p0[r]=NEG; if(kv+32>qrel)p1[r]=NEG;}
}

constexpr int NSLOT=3, SLOTB=8192;
constexpr int LDS_K=0, LDS_V=NSLOT*SLOTB, LDS_WS=2*NSLOT*SLOTB, LDS_OST=LDS_WS+NW*64*4, LDS_NF=LDS_OST+NW*4096, LDS_BYTES=LDS_NF+SEQ*4;
constexpr float C2=0.125f*1.4426950408889634f;
__device__ __forceinline__ void glds16(const void*gsrc,unsigned lds_dst){unsigned keep;
  asm volatile("s_mov_b32 %0, m0\n\ts_mov_b32 m0, %2\n\ts_nop 0\n\tglobal_load_lds_dwordx4 %1, off\n\ts_mov_b32 m0, %0":"=&s"(keep):"v"(gsrc),"s"(lds_dst):"memory");}
__device__ __forceinline__ float max3f(float a,float b,float c){float r;asm("v_max3_f32 %0, %1, %2, %3":"=v"(r):"v"(a),"v"(b),"v"(c));return r;}
__device__ __forceinline__ float max2f(float a,float b){float r;asm("v_max_f32_e32 %0, %1, %2":"=v"(r):"v"(a),"v"(b));return r;}
__device__ __forceinline__ float fadd_s(float a,float b){float r;asm("v_add_f32_e32 %0, %1, %2":"=v"(r):"v"(a),"v"(b));return r;}
__device__ __forceinline__ float fsub_s(float a,float b){float r;asm("v_sub_f32_e32 %0, %1, %2":"=v"(r):"v"(a),"v"(b));return r;}
typedef float f32x2_t __attribute__((ext_vector_type(2))); typedef __bf16 bf16x2_t __attribute__((ext_vector_type(2)));
__device__ __forceinline__ unsigned cvtpk_s(float lo,float hi){f32x2_t v={lo,hi};bf16x2_t b=__builtin_convertvector(v,bf16x2_t);return __builtin_bit_cast(unsigned,b);}
#define WAIT_BAR(N) asm volatile("s_waitcnt vmcnt(" #N ") lgkmcnt(0)\n\ts_barrier":::"memory")

__device__ __forceinline__ void qkt(f32x16&p0,f32x16&p1,const char*Kslot,const bf16x8*qr,float a0,float a1,float bq,int r32,int hi){
  const char*kb=Kslot+hi*1024+r32*16;
  #pragma unroll
  for(int d0=0;d0<4;++d0){
    const bf16x8 b0=*reinterpret_cast<const bf16x8*>(kb+d0*2048);
    const bf16x8 b1=*reinterpret_cast<const bf16x8*>(kb+d0*2048+512);
    if(d0==0){const f32x16 z=f32x16{};p0=__builtin_amdgcn_mfma_f32_32x32x2f32(a0,bq,z,0,0,0);p1=__builtin_amdgcn_mfma_f32_32x32x2f32(a1,bq,z,0,0,0);}
    p0=__builtin_amdgcn_mfma_f32_32x32x16_bf16(b0,qr[d0],p0,0,0,0);p1=__builtin_amdgcn_mfma_f32_32x32x16_bf16(b1,qr[d0],p1,0,0,0);}
}
typedef __attribute__((address_space(3))) const char* lds_cptr;
typedef short v4i16_t __attribute__((ext_vector_type(4)));
__device__ __forceinline__ void kload8(bf16x8*kf,lds_cptr kp){
  kf[0]=*(const __attribute__((address_space(3))) bf16x8*)(kp);      kf[1]=*(const __attribute__((address_space(3))) bf16x8*)(kp+512);
  kf[2]=*(const __attribute__((address_space(3))) bf16x8*)(kp+2048); kf[3]=*(const __attribute__((address_space(3))) bf16x8*)(kp+2560);
  kf[4]=*(const __attribute__((address_space(3))) bf16x8*)(kp+4096); kf[5]=*(const __attribute__((address_space(3))) bf16x8*)(kp+4608);
  kf[6]=*(const __attribute__((address_space(3))) bf16x8*)(kp+6144); kf[7]=*(const __attribute__((address_space(3))) bf16x8*)(kp+6656);
}
__device__ __forceinline__ void kload2(bf16x8*kf,lds_cptr kp,int j){ kf[2*j]=*(const __attribute__((address_space(3))) bf16x8*)(kp+j*2048); kf[2*j+1]=*(const __attribute__((address_space(3))) bf16x8*)(kp+j*2048+512); }
__device__ __forceinline__ s16x4 vtr(lds_cptr p){ return __builtin_bit_cast(s16x4,__builtin_amdgcn_ds_read_tr16_b64_v4i16((__attribute__((address_space(3))) v4i16_t*)p)); }
__device__ __forceinline__ float rowmax(const f32x16&p0,const f32x16&p1){
  float a=max3f(p0[0],p0[1],p1[0]),b=max3f(p0[2],p0[3],p1[1]);a=max3f(a,p1[2],p1[3]);
  #pragma unroll
  for(int r=4;r<16;r+=4){a=max3f(a,p0[r],p0[r+1]);b=max3f(b,p0[r+2],p0[r+3]);a=max3f(a,p1[r],p1[r+1]);b=max3f(b,p1[r+2],p1[r+3]);}
  const float m=max2f(a,b);
  auto rr=__builtin_amdgcn_permlane32_swap(__float_as_uint(m),__float_as_uint(m),false,false);
  return max2f(__uint_as_float(rr[0]),__uint_as_float(rr[1]));
}
__device__ __forceinline__ void pv(f32x16*o,int vb,bf16x8 pa0,bf16x8 pa1,bf16x8 pa2,bf16x8 pa3){
  #pragma unroll
  for(int d0=0;d0<2;++d0){s16x4 lo[4],hi[4];
    #pragma unroll
    for(int ks=0;ks<4;++ks){
      asm volatile("ds_read_b64_tr_b16 %0,%1 offset:%c2":"=&v"(lo[ks]):"v"(vb),"i"(d0*4096+ks*1024):"memory");
      asm volatile("ds_read_b64_tr_b16 %0,%1 offset:%c2":"=&v"(hi[ks]):"v"(vb),"i"(d0*4096+ks*1024+512):"memory");}
    asm volatile("s_waitcnt lgkmcnt(0)":::"memory");SBAR();
    #define PK(k) (bf16x8){lo[k][0],lo[k][1],lo[k][2],lo[k][3],hi[k][0],hi[k][1],hi[k][2],hi[k][3]}
    o[d0]=__builtin_amdgcn_mfma_f32_32x32x16_bf16(pa0,PK(0),o[d0],0,0,0);
    o[d0]=__builtin_amdgcn_mfma_f32_32x32x16_bf16(pa1,PK(1),o[d0],0,0,0);
    o[d0]=__builtin_amdgcn_mfma_f32_32x32x16_bf16(pa2,PK(2),o[d0],0,0,0);
    o[d0]=__builtin_amdgcn_mfma_f32_32x32x16_bf16(pa3,PK(3),o[d0],0,0,0);
    #undef PK
  }
}

#ifndef ATTN_STORE16
#define ATTN_STORE16(p,v) (*(u32x4*)(p)=(v))
#endif
template<int THRL> __device__ __forceinline__ void attn_unit(int b,int h,int qb,const bf16*Q,const bf16*__restrict__ K,const bf16*__restrict__ V,bf16*O,const float*NFg,float thrb,char*shm){
  const int tid=threadIdx.x,lane=tid&63,r32=lane&31,hi=lane>>5; const int wid=__builtin_amdgcn_readfirstlane(tid>>6);
  const long rowbase=(long)b*SEQ; const int q0=qb*QB;
  const int NTfull=(q0+QB)/KVBLK; int ts;
  { const float nfq0=NFg[q0]; const int t0=lane,t1=lane+64;
    const bool s0=(t0<NTfull)&&(nfq0-NFg[64*(t0<NTfull?t0:0)+63]>thrb), s1=(t1<NTfull)&&(nfq0-NFg[64*(t1<NTfull?t1:0)+63]>thrb);
    ts=__popcll(__ballot(s0))+__popcll(__ballot(s1)); ts&=~1; ts=ts<NTfull-4?ts:NTfull-4; ts=__builtin_amdgcn_readfirstlane(ts); }
  const bf16*Qw=Q+(rowbase+q0+wid*QBLK)*PQ+h*D;
  const bf16*Kh=K+rowbase*PQ+h*D,*Vh=V+rowbase*PQ+h*D;
  { typedef float f4_t __attribute__((ext_vector_type(4))); __attribute__((address_space(3))) f4_t* nfw=(__attribute__((address_space(3))) f4_t*)((__attribute__((address_space(3))) char*)shm+LDS_NF);
    const f4_t* nfg=(const f4_t*)NFg; for(int i=ts*16+tid;i<64*(qb+1);i+=NW*64)nfw[i]=nfg[i]; }
  const __attribute__((address_space(3))) float* nfl=(const __attribute__((address_space(3))) float*)((__attribute__((address_space(3))) char*)shm+LDS_NF);
  const unsigned lds0=(unsigned)(uintptr_t)shm;
  float*wsf=(float*)(shm+LDS_WS)+wid*64;
  const bf16*ksrc=Kh+(long)(ts*KVBLK+lane)*PQ+wid*8;
  const bf16*vsrc=Vh+(long)(ts*KVBLK+16*(wid&3)+(lane>>2))*PQ+(wid>>2)*32+(lane&3)*8;
  const unsigned kdst=lds0+LDS_K+wid*1024, vdst=lds0+LDS_V+wid*1024;
  #define DMA_K(t,slot) glds16(ksrc+(long)(t)*KVBLK*PQ,(unsigned)__builtin_amdgcn_readfirstlane(kdst+(slot)))
  #define DMA_V(t,slot) glds16(vsrc+(long)(t)*KVBLK*PQ,(unsigned)__builtin_amdgcn_readfirstlane(vdst+(slot)))
  const int vb0=(int)(lds0+LDS_V)+((lane>>4)&1)*32+(lane&3)*8+(4*hi+((lane&15)>>2))*64;
  const char*Kbase=shm+LDS_K; bf16x8 kf[8];
  const lds_cptr shm3=(lds_cptr)shm; const lds_cptr kp0=shm3+LDS_K+hi*1024+r32*16; const lds_cptr vp0=shm3+LDS_V+((lane>>4)&1)*32+(lane&3)*8+(4*hi+((lane&15)>>2))*64;
  const int NT=NTfull-ts;
  DMA_K(0,0);DMA_V(0,0);DMA_K(1,SLOTB);
  bf16x8 qr[4];
  #pragma unroll
  for(int d0=0;d0<4;++d0)qr[d0]=*reinterpret_cast<const bf16x8*>(&Qw[(long)r32*PQ+d0*16+hi*8]);
  float mhat=0.f,l_reg=0.f,bq=0.f;f32x16 o[2];o[0]=f32x16{};o[1]=f32x16{};
  #define BQ() (hi?-mhat:1.f)
  const __attribute__((address_space(3))) float* nfl_t=nfl+ts*64;
  #define NFA(t,half) (hi?1.f:nfl_t[(t)*64+(half)*32+r32])
  const int qrel=wid*QBLK+r32;
  #define CMASK(P0,P1,t) do{int jb_=(t)-(NT-4); if(jb_>=0)cmask(P0,P1,jb_,qrel,hi);}while(0)
  bool resc=false;
  #define START(P0,P1) do{ const float rm=rowmax(P0,P1); resc=false; \
    { const float dl=__builtin_fmaxf(rm,0.f); mhat=fadd_s(mhat,dl); \
      _Pragma("unroll") for(int r=0;r<16;++r){P0[r]=fsub_s(P0[r],dl);P1[r]=fsub_s(P1[r],dl);} \
      bq=BQ(); } \
    _Pragma("unroll") for(int r=0;r<16;++r)P0[r]=__builtin_amdgcn_exp2f(P0[r]); }while(0)
  #define RESC() do{ if(resc){ asm volatile("s_waitcnt lgkmcnt(0)":::"memory"); \
      _Pragma("unroll") for(int d_=0;d_<2;++d_) _Pragma("unroll") for(int r=0;r<16;++r)o[d_][r]*=wsf[crow(r,hi)]; } }while(0)
  f32x16 pA0,pA1,pB0,pB1;
  int sl_prev=0,sl_cur=0,sl_next=SLOTB;
  #define ROT() do{sl_prev=sl_cur;sl_cur=sl_next;sl_next=(sl_next==(NSLOT-1)*SLOTB)?0:sl_next+SLOTB;}while(0)
  DMA_K(2,2*SLOTB);
  WAIT_BAR(3);
  mhat=nfl[q0+wid*QBLK+r32]; bq=BQ();
  qkt(pA0,pA1,Kbase,qr,NFA(0,0),NFA(0,1),bq,r32,hi);asm volatile("s_nop 15\n\ts_nop 7":"+v"(pA0),"+v"(pA1));CMASK(pA0,pA1,0);
  START(pA0,pA1);
  _Pragma("unroll") for(int r=0;r<16;++r)pA1[r]=__builtin_amdgcn_exp2f(pA1[r]);
  WAIT_BAR(0);
  DMA_K(3,0);DMA_V(1,SLOTB);
  ROT();
  kload8(kf,kp0+sl_cur);
  WAIT_BAR(2);
  s16x4 vlo[8],vhi[8]; u32x4 pw0,pw1,pw2,pw3;
  #define PKW(P,B) cvtpk_s(P[B],P[B+1])
  #define PAF(k) __builtin_bit_cast(bf16x8,pw##k)
  #define VFR(i) (bf16x8){vlo[i][0],vlo[i][1],vlo[i][2],vlo[i][3],vhi[i][0],vhi[i][1],vhi[i][2],vhi[i][3]}
  #define PIN(x) asm volatile("":"+v"(x))
  #define MX3(a,b,c) __builtin_fmaxf(__builtin_fmaxf((a),(b)),(c))
  #define GAPA(MF,A0,A1,A2,A3,W0,W1,PW) do{ MF; sacc+=A0; sacc+=A1; sacc+=A2; sacc+=A3; PIN(sacc); W0; W1; PIN(PW); SBAR(); }while(0)
  #define EX(v) __builtin_amdgcn_exp2f(v)
  #define GAPB(MF,X,B) do{ MF; X[B]=EX(X[B]); X[B+1]=EX(X[B+1]); X[B+2]=EX(X[B+2]); X[B+3]=EX(X[B+3]); PIN(X); SBAR(); }while(0)
  #define VRD(i) do{ vlo[i]=vtr(vp_+(((i)>>2)*4096+((i)&3)*1024)); vhi[i]=vtr(vp_+(((i)>>2)*4096+((i)&3)*1024+512)); }while(0)
  #define KRD(G,j) do{ if(G){ kload2(kf,kp0+sl_next,j); SBAR(); } }while(0)
  #define STEP(C0,C1,P0,P1,t,GK,GV,GL) do{ SBAR(); \
    const lds_cptr vp_=vp0+sl_prev; \
    { const float a0_=NFA(t,0),a1_=NFA(t,1); const f32x16 z_=f32x16{}; C0=__builtin_amdgcn_mfma_f32_32x32x2f32(a0_,bq,z_,0,0,0); C1=__builtin_amdgcn_mfma_f32_32x32x2f32(a1_,bq,z_,0,0,0); } SBAR(); \
    VRD(0); SBAR(); float sacc=(P0[0]+P0[1]); \
    GAPA(C0=__builtin_amdgcn_mfma_f32_32x32x16_bf16(kf[0],qr[0],C0,0,0,0), P0[2],P0[3],P0[4],P0[5],     pw0[0]=PKW(P0,0), pw0[1]=PKW(P0,2), pw0); \
    VRD(4); SBAR(); GAPA(C1=__builtin_amdgcn_mfma_f32_32x32x16_bf16(kf[1],qr[0],C1,0,0,0), P0[6],P0[7],P0[8],P0[9],     pw0[2]=PKW(P0,4), pw0[3]=PKW(P0,6), pw0); \
    VRD(1); SBAR(); GAPA(C0=__builtin_amdgcn_mfma_f32_32x32x16_bf16(kf[2],qr[1],C0,0,0,0),   P0[10],P0[11],P0[12],P0[13], pw1[0]=PKW(P0,8), pw1[1]=PKW(P0,10), pw1); \
    VRD(5); SBAR(); GAPA(C1=__builtin_amdgcn_mfma_f32_32x32x16_bf16(kf[3],qr[1],C1,0,0,0),   P0[14],P0[15],P1[0],P1[1],   pw1[2]=PKW(P0,12),pw1[3]=PKW(P0,14), pw1); \
    VRD(2); SBAR(); GAPA(C0=__builtin_amdgcn_mfma_f32_32x32x16_bf16(kf[4],qr[2],C0,0,0,0),   P1[2],P1[3],P1[4],P1[5],     pw2[0]=PKW(P1,0), pw2[1]=PKW(P1,2), pw2); \
    VRD(6); SBAR(); GAPA(C1=__builtin_amdgcn_mfma_f32_32x32x16_bf16(kf[5],qr[2],C1,0,0,0),   P1[6],P1[7],P1[8],P1[9],     pw2[2]=PKW(P1,4), pw2[3]=PKW(P1,6), pw2); \
    VRD(3); SBAR(); GAPA(C0=__builtin_amdgcn_mfma_f32_32x32x16_bf16(kf[6],qr[3],C0,0,0,0),   P1[10],P1[11],P1[12],P1[13], pw3[0]=PKW(P1,8), pw3[1]=PKW(P1,10), pw3); \
    VRD(7); SBAR(); GAPA(C1=__builtin_amdgcn_mfma_f32_32x32x16_bf16(kf[7],qr[3],C1,0,0,0),   P1[14],P1[15],0.f,0.f,       pw3[2]=PKW(P1,12),pw3[3]=PKW(P1,14), pw3); \
    l_reg+=sacc; \
    if(GK){DMA_K((t)+3,sl_cur);} if(GV){DMA_V((t)+1,sl_next);} \
    CMASK(C0,C1,t); \
    { float a=MX3(C0[0],C0[1],C1[0]),b=MX3(C0[2],C0[3],C1[1]); a=MX3(a,C1[2],C1[3]); \
      _Pragma("unroll") for(int r=4;r<16;r+=4){a=MX3(a,C0[r],C0[r+1]);b=MX3(b,C0[r+2],C0[r+3]);a=MX3(a,C1[r],C1[r+1]);b=MX3(b,C1[r+2],C1[r+3]);} \
      float rm=__builtin_fmaxf(a,b); { auto rr=__builtin_amdgcn_permlane32_swap(__float_as_uint(rm),__float_as_uint(rm),false,false); rm=__builtin_fmaxf(__uint_as_float(rr[0]),__uint_as_float(rr[1])); } \
      resc=false; \
      if(__builtin_expect(__any(rm>(float)THRL),0)){ const float dl=__builtin_fmaxf(rm,0.f); mhat+=dl; \
        _Pragma("unroll") for(int r=0;r<16;++r){C0[r]-=dl;C1[r]-=dl;} \
        bq=BQ(); \
        const float f=__builtin_amdgcn_exp2f(-dl); l_reg*=f; if(hi==0)wsf[r32]=f; resc=true; } } \
    SBAR(); \
    GAPB(o[0]=__builtin_amdgcn_mfma_f32_32x32x16_bf16(PAF(0),VFR(0),o[0],0,0,0), C0,0); \
    GAPB(o[1]=__builtin_amdgcn_mfma_f32_32x32x16_bf16(PAF(0),VFR(4),o[1],0,0,0), C0,4); \
    KRD(GL,0); GAPB(o[0]=__builtin_amdgcn_mfma_f32_32x32x16_bf16(PAF(1),VFR(1),o[0],0,0,0), C0,8); \
    KRD(GL,1); GAPB(o[1]=__builtin_amdgcn_mfma_f32_32x32x16_bf16(PAF(1),VFR(5),o[1],0,0,0), C0,12); \
    KRD(GL,2); GAPB(o[0]=__builtin_amdgcn_mfma_f32_32x32x16_bf16(PAF(2),VFR(2),o[0],0,0,0), C1,0); \
    KRD(GL,3); GAPB(o[1]=__builtin_amdgcn_mfma_f32_32x32x16_bf16(PAF(2),VFR(6),o[1],0,0,0), C1,4); \
    GAPB(o[0]=__builtin_amdgcn_mfma_f32_32x32x16_bf16(PAF(3),VFR(3),o[0],0,0,0), C1,8); \
    GAPB(o[1]=__builtin_amdgcn_mfma_f32_32x32x16_bf16(PAF(3),VFR(7),o[1],0,0,0), C1,12); \
    }while(0)
  int t=1;
  #undef CMASK
  #define CMASK(P0,P1,t) do{}while(0)
  for(;t+5<NT;t+=2){
    STEP(pB0,pB1,pA0,pA1,t,true,true,true);     WAIT_BAR(2); RESC(); ROT();
    STEP(pA0,pA1,pB0,pB1,t+1,true,true,true);   WAIT_BAR(2); RESC(); ROT();
  }
  #undef CMASK
  #define CMASK(P0,P1,t) do{int jb_=(t)-(NT-4); if(jb_>=0)cmask(P0,P1,jb_,qrel,hi);}while(0)
  #define ENDW(tt) do{ if((tt)+3<NT){WAIT_BAR(2);} else if((tt)+2<NT){WAIT_BAR(1);} else {WAIT_BAR(0);} }while(0)
  for(;t+1<NT;t+=2){
    STEP(pB0,pB1,pA0,pA1,t,(t+3<NT),(t+1<NT),(t+1<NT));       ENDW(t);   RESC(); ROT();
    STEP(pA0,pA1,pB0,pB1,t+1,(t+4<NT),(t+2<NT),(t+2<NT));     ENDW(t+1); RESC(); ROT();
  }
  STEP(pB0,pB1,pA0,pA1,NT-1,false,false,false); RESC();
  { float sacc=pB0[0]+pB0[1]; _Pragma("unroll") for(int r=2;r<16;++r)sacc+=pB0[r]; _Pragma("unroll") for(int r=0;r<16;++r)sacc+=pB1[r]; l_reg+=sacc;
    pw0=(u32x4){PKW(pB0,0),PKW(pB0,2),PKW(pB0,4),PKW(pB0,6)};pw1=(u32x4){PKW(pB0,8),PKW(pB0,10),PKW(pB0,12),PKW(pB0,14)};pw2=(u32x4){PKW(pB1,0),PKW(pB1,2),PKW(pB1,4),PKW(pB1,6)};pw3=(u32x4){PKW(pB1,8),PKW(pB1,10),PKW(pB1,12),PKW(pB1,14)};
    SBAR(); pv(o,vb0+sl_cur,PAF(0),PAF(1),PAF(2),PAF(3)); }
  #undef PKW
  #undef PAF
  #undef VFR
  #undef PIN
  #undef MX3
  #undef GAPA
  #undef GAPB
  #undef EX
  #undef VRD
  #undef KRD
  #undef STEP
  #undef ENDW
  {auto rr=__builtin_amdgcn_permlane32_swap(__float_as_uint(l_reg),__float_as_uint(l_reg),false,false);l_reg=__uint_as_float(rr[0])+__uint_as_float(rr[1]);}
  if(hi==0)wsf[32+r32]=l_reg;asm volatile("s_waitcnt lgkmcnt(0)":::"memory");
  float rli[16];
  #pragma unroll
  for(int r=0;r<16;++r)rli[r]=__builtin_amdgcn_rcpf(wsf[32+crow(r,hi)]);
  bf16*Ow=O+(rowbase+q0+wid*QBLK)*PO+h*D;
  { bf16*stg=(bf16*)(shm+LDS_OST)+wid*2048;
    #pragma unroll
    for(int r=0;r<16;++r){const int orow=crow(r,hi);
      #pragma unroll
      for(int d0=0;d0<2;++d0)stg[orow*64+d0*32+r32]=__float2bfloat16(o[d0][r]*rli[r]);}
    asm volatile("s_waitcnt lgkmcnt(0)":::"memory");
    #pragma unroll
    for(int i=0;i<4;++i){const int row=i*8+(lane>>3),ch=lane&7; const u32x4 v=*(const u32x4*)(stg+row*64+ch*8); ATTN_STORE16(Ow+(long)row*PO+ch*8,v);} }
  asm volatile("s_waitcnt lgkmcnt(0)\n\ts_barrier":::"memory");
  #undef DMA_K
  #undef DMA_V
  #undef CMASK
  #undef START
  #undef RESC
  #undef ROT
  #undef BQ
  #undef NFA
}
constexpr int ATTN_LDS_BYTES=LDS_BYTES;
struct AttnTensors { const bf16* Q; const bf16* K; const bf16* V; bf16* O; const float* NF; const float* udmin;   const unsigned* qk2max;   };
struct AttnUnit { int bh; int qb; };
struct StaticOrder {
  int vcu;
  __device__ __forceinline__ explicit StaticOrder(int grid,int block):vcu((block%8)*(grid/8)+block/8){}
  __device__ __forceinline__ bool next(int i,AttnUnit&u)const{ if(i>=4)return false; const int s=vcu&7; u.bh=vcu>>3; u.qb=(i==0)?s:(i==1)?15-s:(i==2)?16+s:31-s; return true; }
  __device__ __forceinline__ void a_ready(const AttnUnit&)const{}
  __device__ __forceinline__ void done(const AttnUnit&)const{}
};
constexpr int ATT_TAB=LDS_BYTES;
template<int THRL=8> __device__ __forceinline__ void attn_phase_queue(char*lds,const AttnTensors&T,unsigned*queue){
  typedef __attribute__((address_space(3))) float lfloat; typedef __attribute__((address_space(3))) int lint;
  lfloat*thr_l=(lfloat*)((__attribute__((address_space(3))) char*)lds+ATT_TAB); lint*cnt_l=(lint*)(thr_l+32); lint*ord_l=cnt_l+32; lint*idx_l=ord_l+32; lfloat*udm_l=thr_l+128;
  const int tid=threadIdx.x;
  if(tid<32){ const float q2=__uint_as_float(__hip_atomic_load(T.qk2max+tid,__ATOMIC_RELAXED,__HIP_MEMORY_SCOPE_AGENT)),k2=__uint_as_float(__hip_atomic_load(T.qk2max+32+tid,__ATOMIC_RELAXED,__HIP_MEMORY_SCOPE_AGENT));
    thr_l[tid]=sqrtf(q2*k2)+40.f; cnt_l[tid]=0; }
  { int i0=tid; asm volatile("":"+v"(i0)); for(int i=i0;i<1024;i+=NW*64)udm_l[i]=T.udmin[i]; }
  __syncthreads();
  { const int bh=tid>>4,part=tid&15; const float*nf=T.NF+(size_t)bh*SEQ; const float nfq0=nf[31*QB],th=thr_l[bh]-udm_l[bh*32+31]; int c=0;
    #pragma unroll
    for(int i=0;i<8;++i)c+=(nfq0-nf[64*(part*8+i)+63]>th)?1:0;
    __hip_atomic_fetch_add(cnt_l+bh,c,__ATOMIC_RELAXED,__HIP_MEMORY_SCOPE_WORKGROUP); }
  __syncthreads();
  if(tid<32){ const int mine=cnt_l[tid]; int rank=0;
    for(int j=0;j<32;++j){ const int o=cnt_l[j]; rank+=(o<mine||(o==mine&&j<tid))?1:0; }
    ord_l[rank]=tid; }
  __syncthreads();
  for(;;){
    if(tid==0)idx_l[0]=(int)__hip_atomic_fetch_add(queue,1u,__ATOMIC_RELAXED,__HIP_MEMORY_SCOPE_AGENT);
    __syncthreads();
    const int idx=__builtin_amdgcn_readfirstlane(idx_l[0]);
    if(idx>=BATCH*NHEAD*NQB)break;
    const int bh=__builtin_amdgcn_readfirstlane(ord_l[idx>>5]),qb=31-(idx&31);
    const float thrb=__builtin_bit_cast(float,__builtin_amdgcn_readfirstlane(__builtin_bit_cast(int,thr_l[bh]-udm_l[bh*32+qb])));
    attn_unit<THRL>(bh/NHEAD,bh%NHEAD,qb,T.Q,T.K,T.V,T.O,T.NF+(size_t)bh*SEQ,thrb,lds);
  }
}
#undef SBAR
#undef WAIT_BAR
}


namespace gla {
typedef short bf16x8 __attribute__((ext_vector_type(8)));
typedef short s16x4 __attribute__((ext_vector_type(4)));
typedef float f32x4 __attribute__((ext_vector_type(4)));
typedef unsigned u32x4 __attribute__((ext_vector_type(4)));
#define GL_LAS __attribute__((address_space(3)))
constexpr int AST = 272, KST = 144, BST = 272;
constexpr int L_A = 0, L_K = 17408, L_B = 26624, L_Z = 61440, L_TOT = 65536, L_SS = 67584, L_END = 69632;
constexpr int NCH = 2048;
__device__ __forceinline__ s16x4 tr4(GL_LAS const unsigned char* p) { return __builtin_bit_cast(s16x4, __builtin_amdgcn_ds_read_tr16_b64_v4i16((GL_LAS s16x4*)p)); }
__device__ __forceinline__ float logsig_fast(float x) { return fminf(x, 0.f) - __logf(1.f + __expf(-fabsf(x))); }

struct UnitIn { u32x4 v[2], sp[2]; f32x4 z; unsigned short q[8], k[8], g[16]; uint2 gp[4]; };
template <bool PC>
__device__ __forceinline__ void unit_load(UnitIn& R, int ch, const bf16_t* P, const float* ZF, const bf16_t* SP, int tid, int wave, int lane) {
    const int bh = ch >> 7, n = ch & 127, b = bh >> 2, h = bh & 3; const size_t row0 = (size_t)b * S + n * 64;
#pragma unroll
    for (int u = 0; u < 2; ++u) { const int c = tid + 512 * u, row = c >> 4, chn = c & 15;
        R.v[u] = *(const u32x4*)(P + (row0 + row) * NPROJ + PC_VG + h * 128 + chn * 8);
        if (PC) R.sp[u] = *(const u32x4*)(SP + (size_t)ch * 8192 + row * 128 + chn * 8); }
    { const int t = (tid & 255) >> 2, r4 = (tid & 3) * 4; R.z = *(const f32x4*)(ZF + (row0 + t) * 32 + r4); }
#pragma unroll
    for (int i = 0; i < 8; ++i) { R.k[i] = P[(row0 + 8 * wave + i) * NPROJ + PC_KG + h * 64 + lane]; if (PC) R.q[i] = P[(row0 + 8 * wave + i) * NPROJ + PC_QG + h * 64 + lane]; }
    if (PC) { const int fr = lane & 15, fq = lane >> 4;
#pragma unroll
        for (int it = 0; it < 4; ++it)
#pragma unroll
            for (int r = 0; r < 4; ++r) R.g[it * 4 + r] = P[(row0 + 16 * it + 4 * fq + r) * NPROJ + PC_GG + h * 128 + 16 * wave + fr]; }
    asm volatile("" ::: "memory");
}
template <bool PC>
__device__ __forceinline__ void chunk_decay(GL_LAS unsigned char* lds, const UnitIn& R, const float (&wk)[16], float bk, int tid, int wave, int lane, float (&bcs)[8], float& blast) {
    GL_LAS float* zs = (GL_LAS float*)(lds + L_Z); GL_LAS float* tot = (GL_LAS float*)(lds + L_TOT);
#pragma unroll
    for (int u = 0; u < 2; ++u) { const int c = tid + 512 * u, row = c >> 4, chn = c & 15;
        *(GL_LAS u32x4*)(lds + L_B + row * BST + chn * 16) = R.v[u];
        if (PC) *(GL_LAS u32x4*)(lds + L_B + (64 + row) * BST + chn * 16) = R.sp[u]; }
    if (tid < 256) { const int t = tid >> 2, r4 = (tid & 3) * 4; *(GL_LAS f32x4*)(zs + t * 16 + r4) = R.z; }
    __syncthreads();
    float run = 0.f;
#pragma unroll
    for (int i = 0; i < 8; ++i) { const int t = 8 * wave + i; float gk = bk;
#pragma unroll
        for (int r4 = 0; r4 < 4; ++r4) { const f32x4 z = *(GL_LAS const f32x4*)(zs + t * 16 + r4 * 4); gk += z[0] * wk[r4 * 4] + z[1] * wk[r4 * 4 + 1] + z[2] * wk[r4 * 4 + 2] + z[3] * wk[r4 * 4 + 3]; }
        run += logsig_fast(gk) * (1.f / 16.f); bcs[i] = run; }
    tot[wave * 64 + lane] = run;
    __syncthreads();
    float base = 0.f, all = 0.f;
#pragma unroll
    for (int w = 0; w < 8; ++w) { const float t = tot[w * 64 + lane]; all += t; if (w < wave) base += t; }
#pragma unroll
    for (int i = 0; i < 8; ++i) bcs[i] += base;
    blast = all;
}

__device__ __forceinline__ void phase_a_unit(GL_LAS unsigned char* lds, int ch, const UnitIn& R, const float (&wk)[16], float bk, float* KV, float* DEC) {
    const int tid = threadIdx.x, lane = tid & 63, wave = __builtin_amdgcn_readfirstlane(tid >> 6);
    float bcs[8], blast;
    chunk_decay<false>(lds, R, wk, bk, tid, wave, lane, bcs, blast);
    { u32x4 w;
      w.x = pk2(bf2f(R.k[0]) * __expf(blast - bcs[0]), bf2f(R.k[1]) * __expf(blast - bcs[1])); w.y = pk2(bf2f(R.k[2]) * __expf(blast - bcs[2]), bf2f(R.k[3]) * __expf(blast - bcs[3]));
      w.z = pk2(bf2f(R.k[4]) * __expf(blast - bcs[4]), bf2f(R.k[5]) * __expf(blast - bcs[5])); w.w = pk2(bf2f(R.k[6]) * __expf(blast - bcs[6]), bf2f(R.k[7]) * __expf(blast - bcs[7]));
      *(GL_LAS u32x4*)(lds + L_K + lane * KST + wave * 16) = w;
      if (wave == 0) DEC[(size_t)ch * 64 + lane] = __expf(blast); }
    __syncthreads();
    { const int mt = wave & 3, ng = wave >> 2, fr = lane & 15, fq = lane >> 4, q = fr >> 2, p = fr & 3;
      f32x4 acc[4];
#pragma unroll
      for (int t = 0; t < 4; ++t) acc[t] = (f32x4){0.f, 0.f, 0.f, 0.f};
#pragma unroll
      for (int ks = 0; ks < 2; ++ks) {
          const bf16x8 a = *(GL_LAS const bf16x8*)(lds + L_K + (16 * mt + fr) * KST + (32 * ks + 8 * fq) * 2);
#pragma unroll
          for (int t = 0; t < 4; ++t) { const int nt = ng * 4 + t; GL_LAS const unsigned char* bp = lds + L_B + (32 * ks + 8 * fq + q) * BST + (16 * nt + 4 * p) * 2;
              const s16x4 lo = tr4(bp), hi = tr4(bp + 4 * BST);
              const bf16x8 bb = (bf16x8){lo[0], lo[1], lo[2], lo[3], hi[0], hi[1], hi[2], hi[3]};
              acc[t] = __builtin_amdgcn_mfma_f32_16x16x32_bf16(bb, a, acc[t], 0, 0, 0); } }
#pragma unroll
      for (int t = 0; t < 4; ++t) { const int nt = ng * 4 + t; uint2 w; w.x = pk2(acc[t][0], acc[t][1]); w.y = pk2(acc[t][2], acc[t][3]);
          *(uint2*)((bf16_t*)KV + (size_t)ch * 8192 + (16 * mt + fr) * 128 + 16 * nt + 4 * fq) = w; } }
    __syncthreads();
}

__device__ __forceinline__ void phase_c_unit(GL_LAS unsigned char* lds, int ch, const UnitIn& R, const float (&wk)[16], float bk, const float* gain, bf16_t* AO) {
    const int tid = threadIdx.x, lane = tid & 63, wave = __builtin_amdgcn_readfirstlane(tid >> 6);
    const int bh = ch >> 7, n = ch & 127, b = bh >> 2, h = bh & 3; const size_t row0 = (size_t)b * S + n * 64;
    float bcs[8], blast;
    chunk_decay<true>(lds, R, wk, bk, tid, wave, lane, bcs, blast);
#pragma unroll
    for (int i = 0; i < 8; ++i) { const int t = 8 * wave + i;
        *(GL_LAS bf16_t*)(lds + L_A + t * AST + (64 + lane) * 2) = (bf16_t)f2bf(bf2f(R.q[i]) * __expf(bcs[i]) * 0.125f);
        *(GL_LAS bf16_t*)(lds + L_K + t * KST + lane * 2) = (bf16_t)f2bf(bf2f(R.k[i]) * __expf(-bcs[i])); }
    __syncthreads();
    const int fr = lane & 15, fq = lane >> 4, q = fr >> 2, p = fr & 3;
    { const int it = wave >> 1;
#pragma unroll
      for (int u = 0; u < 2; ++u) { const int jt = 2 * (wave & 1) + u;
          f32x4 acc = (f32x4){0.f, 0.f, 0.f, 0.f};
          if (jt <= it) {
#pragma unroll
              for (int ks = 0; ks < 2; ++ks) {
                  const bf16x8 a = *(GL_LAS const bf16x8*)(lds + L_A + (16 * it + fr) * AST + (64 + 32 * ks + 8 * fq) * 2);
                  const bf16x8 bb = *(GL_LAS const bf16x8*)(lds + L_K + (16 * jt + fr) * KST + (32 * ks + 8 * fq) * 2);
                  acc = __builtin_amdgcn_mfma_f32_16x16x32_bf16(a, bb, acc, 0, 0, 0); } }
#pragma unroll
          for (int r = 0; r < 4; ++r) { const int i = 16 * it + 4 * fq + r, j = 16 * jt + fr;
              *(GL_LAS bf16_t*)(lds + L_A + i * AST + j * 2) = (bf16_t)f2bf(j <= i ? acc[r] : 0.f); } } }
    __syncthreads();
    f32x4 o[4];
#pragma unroll
    for (int it = 0; it < 4; ++it) o[it] = (f32x4){0.f, 0.f, 0.f, 0.f};
#pragma unroll
    for (int ks = 0; ks < 4; ++ks) { GL_LAS const unsigned char* bp = lds + L_B + (32 * ks + 8 * fq + q) * BST + (16 * wave + 4 * p) * 2;
        const s16x4 lo = tr4(bp), hi = tr4(bp + 4 * BST);
        const bf16x8 bb = (bf16x8){lo[0], lo[1], lo[2], lo[3], hi[0], hi[1], hi[2], hi[3]};
#pragma unroll
        for (int it = 0; it < 4; ++it) { const bf16x8 a = *(GL_LAS const bf16x8*)(lds + L_A + (16 * it + fr) * AST + (32 * ks + 8 * fq) * 2);
            o[it] = __builtin_amdgcn_mfma_f32_16x16x32_bf16(a, bb, o[it], 0, 0, 0); } }
    GL_LAS float* ssb = (GL_LAS float*)(lds + L_SS);
#pragma unroll
    for (int it = 0; it < 4; ++it)
#pragma unroll
        for (int r = 0; r < 4; ++r) { float s = o[it][r] * o[it][r];
            s = row16_sum(s);
            if (fr == 0) ssb[(16 * it + 4 * fq + r) * 8 + wave] = s; }
    __syncthreads();
    { const int v = 16 * wave + fr; const float gn = gain[h * 128 + v];
#pragma unroll
      for (int it = 0; it < 4; ++it)
#pragma unroll
          for (int r = 0; r < 4; ++r) { const int i = 16 * it + 4 * fq + r;
              const f32x4 s0 = *(GL_LAS const f32x4*)(ssb + i * 8), s1 = *(GL_LAS const f32x4*)(ssb + i * 8 + 4);
              const float rstd = rsqrtf(((s0[0] + s0[1]) + (s0[2] + s0[3]) + (s1[0] + s1[1]) + (s1[2] + s1[3])) * (1.f / 128.f) + EPS);
              const float g = bf2f(R.g[it * 4 + r]);
              AO[(row0 + i) * 1024 + h * 128 + v] = (bf16_t)f2bf(o[it][r] * rstd * gn * g * __builtin_amdgcn_rcpf(1.f + __expf(-g))); } }
    __syncthreads();
}
constexpr int SM_Z = 0, SM_TOT = 4096, SM_SS = 6144;
__device__ __forceinline__ void c_load_vsz(UnitIn& R, int ch, const bf16_t* P, const float* ZF, const bf16_t* SP, int tid) {
    const int bh = ch >> 7, n = ch & 127, b = bh >> 2, h = bh & 3; const size_t row0 = (size_t)b * S + n * 64;
#pragma unroll
    for (int u = 0; u < 2; ++u) { const int c = tid + 512 * u, row = c >> 4, chn = c & 15;
        R.v[u] = *(const u32x4*)(P + (row0 + row) * NPROJ + PC_VG + h * 128 + chn * 8);
        R.sp[u] = *(const u32x4*)(SP + (size_t)ch * 8192 + row * 128 + chn * 8); }
    { const int t = (tid & 255) >> 2, r4 = (tid & 3) * 4; R.z = *(const f32x4*)(ZF + (row0 + t) * 32 + r4); }
}
__device__ __forceinline__ void c_load_qk(UnitIn& R, int ch, const bf16_t* P, int wave, int lane) {
    const int bh = ch >> 7, n = ch & 127, b = bh >> 2, h = bh & 3; const size_t row0 = (size_t)b * S + n * 64;
#pragma unroll
    for (int i = 0; i < 8; ++i) { R.k[i] = P[(row0 + 8 * wave + i) * NPROJ + PC_KG + h * 64 + lane]; R.q[i] = P[(row0 + 8 * wave + i) * NPROJ + PC_QG + h * 64 + lane]; }
}
__device__ __forceinline__ void c_load_g(UnitIn& R, int ch, const bf16_t* P, int wave, int lane) {
    const int bh = ch >> 7, n = ch & 127, b = bh >> 2, h = bh & 3; const size_t row0 = (size_t)b * S + n * 64; const int fr = lane & 15, fq = lane >> 4;
#pragma unroll
    for (int it = 0; it < 4; ++it) R.gp[it] = *(const uint2*)(P + (row0 + 16 * it + fr) * NPROJ + PC_GG + h * 128 + 16 * wave + 4 * fq);
}
__device__ __forceinline__ void c_s1(GL_LAS unsigned char* img, GL_LAS unsigned char* sm, const UnitIn& R, int tid) {
#pragma unroll
    for (int u = 0; u < 2; ++u) { const int c = tid + 512 * u, row = c >> 4, chn = c & 15;
        *(GL_LAS u32x4*)(img + L_B + row * BST + chn * 16) = R.v[u];
        *(GL_LAS u32x4*)(img + L_B + (64 + row) * BST + chn * 16) = R.sp[u]; }
    if (tid < 256) { const int t = tid >> 2, r4 = (tid & 3) * 4; *(GL_LAS f32x4*)((GL_LAS float*)(sm + SM_Z) + t * 16 + r4) = R.z; }
}
__device__ __forceinline__ void c_s2(GL_LAS unsigned char* sm, const float (&wk)[16], float bk, int wave, int lane, float (&bcs)[8]) {
    GL_LAS const float* zs = (GL_LAS const float*)(sm + SM_Z); GL_LAS float* tot = (GL_LAS float*)(sm + SM_TOT);
    float run = 0.f;
#pragma unroll
    for (int i = 0; i < 8; ++i) { const int t = 8 * wave + i; float gk = bk;
#pragma unroll
        for (int r4 = 0; r4 < 4; ++r4) { const f32x4 z = *(GL_LAS const f32x4*)(zs + t * 16 + r4 * 4); gk += z[0] * wk[r4 * 4] + z[1] * wk[r4 * 4 + 1] + z[2] * wk[r4 * 4 + 2] + z[3] * wk[r4 * 4 + 3]; }
        run += logsig_fast(gk) * (1.f / 16.f); bcs[i] = run; }
    tot[wave * 64 + lane] = run;
}
__device__ __forceinline__ void c_s3(GL_LAS unsigned char* img, GL_LAS unsigned char* sm, const UnitIn& R, int wave, int lane, float (&bcs)[8]) {
    GL_LAS const float* tot = (GL_LAS const float*)(sm + SM_TOT);
    float base = 0.f;
#pragma unroll
    for (int w = 0; w < 8; ++w) { const float t = tot[w * 64 + lane]; if (w < wave) base += t; }
#pragma unroll
    for (int i = 0; i < 8; ++i) { const int t = 8 * wave + i; const float bc = bcs[i] + base;
        *(GL_LAS bf16_t*)(img + L_A + t * AST + (64 + lane) * 2) = (bf16_t)f2bf(bf2f(R.q[i]) * __expf(bc) * 0.125f);
        *(GL_LAS bf16_t*)(img + L_K + t * KST + lane * 2) = (bf16_t)f2bf(bf2f(R.k[i]) * __expf(-bc)); }
}
__device__ __forceinline__ void c_s4(GL_LAS unsigned char* img, int wave, int lane) {
    const int fr = lane & 15, fq = lane >> 4; const int it = wave >> 1;
#pragma unroll
    for (int u = 0; u < 2; ++u) { const int jt = 2 * (wave & 1) + u;
        f32x4 acc = (f32x4){0.f, 0.f, 0.f, 0.f};
        if (jt <= it) {
#pragma unroll
            for (int ks = 0; ks < 2; ++ks) {
                const bf16x8 a = *(GL_LAS const bf16x8*)(img + L_A + (16 * it + fr) * AST + (64 + 32 * ks + 8 * fq) * 2);
                const bf16x8 bb = *(GL_LAS const bf16x8*)(img + L_K + (16 * jt + fr) * KST + (32 * ks + 8 * fq) * 2);
                acc = __builtin_amdgcn_mfma_f32_16x16x32_bf16(a, bb, acc, 0, 0, 0); } }
#pragma unroll
        for (int r = 0; r < 4; ++r) { const int i = 16 * it + 4 * fq + r, j = 16 * jt + fr;
            *(GL_LAS bf16_t*)(img + L_A + i * AST + j * 2) = (bf16_t)f2bf(j <= i ? acc[r] : 0.f); } }
}
__device__ __forceinline__ void c_s5(GL_LAS unsigned char* img, GL_LAS unsigned char* sm, int wave, int lane, f32x4 (&o)[4]) {
    const int fr = lane & 15, fq = lane >> 4, q = fr >> 2, p = fr & 3;
#pragma unroll
    for (int it = 0; it < 4; ++it) o[it] = (f32x4){0.f, 0.f, 0.f, 0.f};
#pragma unroll
    for (int ks = 0; ks < 4; ++ks) { GL_LAS const unsigned char* bp = img + L_B + (32 * ks + 8 * fq + q) * BST + (16 * wave + 4 * p) * 2;
        const s16x4 lo = tr4(bp), hi = tr4(bp + 4 * BST);
        const bf16x8 bb = (bf16x8){lo[0], lo[1], lo[2], lo[3], hi[0], hi[1], hi[2], hi[3]};
#pragma unroll
        for (int it = 0; it < 4; ++it) { const bf16x8 a = *(GL_LAS const bf16x8*)(img + L_A + (16 * it + fr) * AST + (32 * ks + 8 * fq) * 2);
            o[it] = __builtin_amdgcn_mfma_f32_16x16x32_bf16(bb, a, o[it], 0, 0, 0); } }
    GL_LAS float* ssb = (GL_LAS float*)(sm + SM_SS);
#pragma unroll
    for (int it = 0; it < 4; ++it) { float s = (o[it][0] * o[it][0] + o[it][1] * o[it][1]) + (o[it][2] * o[it][2] + o[it][3] * o[it][3]);
        s += __shfl_xor(s, 16); s += __shfl_xor(s, 32);
        if (fq == 0) ssb[(16 * it + fr) * 8 + wave] = s; }
}
__device__ __forceinline__ void c_s6(GL_LAS unsigned char* sm, int ch, const UnitIn& R, const float* gain, bf16_t* AO, int wave, int lane, const f32x4 (&o)[4]) {
    const int bh = ch >> 7, n = ch & 127, b = bh >> 2, h = bh & 3; const size_t row0 = (size_t)b * S + n * 64;
    const int fr = lane & 15, fq = lane >> 4; GL_LAS const float* ssb = (GL_LAS const float*)(sm + SM_SS);
    const int v = 16 * wave + 4 * fq; const f32x4 gn = *(const f32x4*)(gain + h * 128 + v);
#pragma unroll
    for (int it = 0; it < 4; ++it) { const int i = 16 * it + fr;
        const f32x4 s0 = *(GL_LAS const f32x4*)(ssb + i * 8), s1 = *(GL_LAS const f32x4*)(ssb + i * 8 + 4);
        const float rstd = rsqrtf(((s0[0] + s0[1]) + (s0[2] + s0[3]) + (s1[0] + s1[1]) + (s1[2] + s1[3])) * (1.f / 128.f) + EPS);
        const float g0 = bf2f(R.gp[it].x & 0xffffu), g1 = bf2f(R.gp[it].x >> 16), g2 = bf2f(R.gp[it].y & 0xffffu), g3 = bf2f(R.gp[it].y >> 16);
        uint2 w;
        w.x = pk2(o[it][0] * rstd * gn[0] * g0 * __builtin_amdgcn_rcpf(1.f + __expf(-g0)), o[it][1] * rstd * gn[1] * g1 * __builtin_amdgcn_rcpf(1.f + __expf(-g1)));
        w.y = pk2(o[it][2] * rstd * gn[2] * g2 * __builtin_amdgcn_rcpf(1.f + __expf(-g2)), o[it][3] * rstd * gn[3] * g3 * __builtin_amdgcn_rcpf(1.f + __expf(-g3)));
        *(uint2*)(AO + (row0 + i) * 1024 + h * 128 + v) = w; }
}
__device__ __forceinline__ void run_pairs_c(GL_LAS unsigned char* lds, int sm1_off, int ch0, int nunits, const bf16_t* P, const float* ZF, const float* w_gk2, const float* b_gk, const bf16_t* SP, const float* gain, bf16_t* AO) {
    const int tid = threadIdx.x, lane = tid & 63, wave = __builtin_amdgcn_readfirstlane(tid >> 6);
    const int h = (ch0 >> 7) & 3;
    float wk[16];
#pragma unroll
    for (int r = 0; r < 16; ++r) wk[r] = w_gk2[r * 256 + h * 64 + lane];
    const float bk = b_gk[h * 64 + lane];
    GL_LAS unsigned char* const img0 = lds; GL_LAS unsigned char* const img1 = lds + 61440;
    GL_LAS unsigned char* const sm0 = lds + 122880; GL_LAS unsigned char* const sm1 = lds + sm1_off;
    UnitIn R0, R1;
    c_load_vsz(R0, ch0, P, ZF, SP, tid); c_load_vsz(R1, ch0 + 1, P, ZF, SP, tid);
    c_load_qk(R0, ch0, P, wave, lane); c_load_qk(R1, ch0 + 1, P, wave, lane);
    c_load_g(R0, ch0, P, wave, lane); c_load_g(R1, ch0 + 1, P, wave, lane);
    asm volatile("" ::: "memory");
#pragma unroll 1
    for (int i = 0; i < nunits; i += 2) {
        const int ca = ch0 + i, cn = ch0 + (i + 2 < nunits ? i + 2 : i);
        float bcs0[8], bcs1[8]; f32x4 o0[4], o1[4];
        c_s1(img0, sm0, R0, tid); c_s1(img1, sm1, R1, tid);
        asm volatile("" ::: "memory");
        c_load_vsz(R0, cn, P, ZF, SP, tid); c_load_vsz(R1, cn + 1, P, ZF, SP, tid);
        asm volatile("" ::: "memory");
        __syncthreads();
        c_s2(sm0, wk, bk, wave, lane, bcs0); c_s2(sm1, wk, bk, wave, lane, bcs1);
        __syncthreads();
        c_s3(img0, sm0, R0, wave, lane, bcs0); c_s3(img1, sm1, R1, wave, lane, bcs1);
        asm volatile("" ::: "memory");
        c_load_qk(R0, cn, P, wave, lane); c_load_qk(R1, cn + 1, P, wave, lane);
        asm volatile("" ::: "memory");
        __syncthreads();
        c_s4(img0, wave, lane); c_s4(img1, wave, lane);
        __syncthreads();
        c_s5(img0, sm0, wave, lane, o0); c_s5(img1, sm1, wave, lane, o1);
        __syncthreads();
        c_s6(sm0, ca, R0, gain, AO, wave, lane, o0); c_s6(sm1, ca + 1, R1, gain, AO, wave, lane, o1);
        asm volatile("" ::: "memory");
        c_load_g(R0, cn, P, wave, lane); c_load_g(R1, cn + 1, P, wave, lane);
        asm volatile("" ::: "memory");
        __syncthreads();
    }
}
template <bool PC>
__device__ __forceinline__ void run_units(GL_LAS unsigned char* lds, int ch0, int nunits, const bf16_t* P, const float* ZF, const float* w_gk2, const float* b_gk, const bf16_t* SP, const float* gain, float* KV, float* DEC, bf16_t* AO) {
    const int tid = threadIdx.x, lane = tid & 63, wave = __builtin_amdgcn_readfirstlane(tid >> 6);
    const int h = (ch0 >> 7) & 3;
    float wk[16];
#pragma unroll
    for (int r = 0; r < 16; ++r) wk[r] = w_gk2[r * 256 + h * 64 + lane];
    const float bk = b_gk[h * 64 + lane];
    UnitIn RA, RB;
    unit_load<PC>(RA, ch0, P, ZF, SP, tid, wave, lane);
#pragma unroll 1
    for (int i = 0; i < nunits; i += 2) {
        unit_load<PC>(RB, ch0 + i + 1, P, ZF, SP, tid, wave, lane);
        if (PC) phase_c_unit(lds, ch0 + i, RA, wk, bk, gain, AO); else phase_a_unit(lds, ch0 + i, RA, wk, bk, KV, DEC);
        unit_load<PC>(RA, ch0 + (i + 2 < nunits ? i + 2 : i), P, ZF, SP, tid, wave, lane);
        if (PC) phase_c_unit(lds, ch0 + i + 1, RB, wk, bk, gain, AO); else phase_a_unit(lds, ch0 + i + 1, RB, wk, bk, KV, DEC);
    }
}
#undef GL_LAS
}

#define LAS __attribute__((address_space(3)))
constexpr int NWAVES = 8, NTHR = 512;
constexpr int RING_BYTES = 131072, LDS_BYTES = 163840;
constexpr size_t WS_WINT = WS_END;
constexpr size_t WS_WOT = WS_WINT + 8 * MiB;
constexpr size_t WS_W1T = WS_WOT + 2 * MiB;
constexpr size_t WS_W2T = WS_W1T + 128 * MiB;
constexpr size_t WS_END2 = WS_W2T + 64 * MiB;
constexpr size_t WS_SLOTE = WS_W1T + 64 * MiB;
constexpr size_t WS_KV = WS_YS;
constexpr size_t WS_SP = WS_YS + 64 * MiB;
constexpr size_t WS_DEC = WS_YS + 96 * MiB;
constexpr size_t WS_LF = WS_YS + 97 * MiB;
constexpr size_t WS_SEGT = WS_YS + 98 * MiB;
constexpr size_t WS_UDMIN = WS_YS + 99 * MiB;

enum Phase { PH_PRO = 0, PH_XN = 1, PH_G1 = 2, PH_GLAA = 3, PH_SCAN = 4, PH_ATTN = 5, PH_WO = 6, PH_ROUTE = 7, PH_PLAN = 8, PH_E1 = 9, PH_E2 = 10, PH_FINAL = 11, PH_COUNT = 12 };

#define RLX_AGENT __ATOMIC_RELAXED, __HIP_MEMORY_SCOPE_AGENT
#define XB_TMO      128
#define XB_XCNT(j)  (256  + 64 * (j))
#define XB_XSUB(j)  (1280 + 64 * (j))
#define XB_XGEN(j)  (2304 + 64 * (j))
#define XB_TOP      3328
#define XB_TOPGEN   3392
#define XCD_BAR_WORDS 3456
#define XB_SPIN_CAP (1u << 18)
constexpr int CW_BAR = 4096;
constexpr int LDSCTL_OFF = RING_BYTES, MISC_OFF = LDSCTL_OFF + 320;
__device__ __forceinline__ unsigned xb_ld(unsigned* p)              { return __hip_atomic_load(p, __ATOMIC_RELAXED, __HIP_MEMORY_SCOPE_AGENT); }
__device__ __forceinline__ unsigned xb_add(unsigned* p, unsigned v) { return __hip_atomic_fetch_add(p, v, __ATOMIC_RELAXED, __HIP_MEMORY_SCOPE_AGENT); }
__device__ __forceinline__ unsigned xb_xcc_id() { return (unsigned)__builtin_amdgcn_s_getreg((3 << 11) | 20) & 0xFu; }
#define XB_SPIN(cond, bar) do { unsigned _sp = 0; while (cond) { __builtin_amdgcn_s_sleep(1); \
    if ((++_sp & 255u) == 0u) { if (xb_ld(&(bar)[XB_TMO])) break; if (_sp > XB_SPIN_CAP) { atomicAdd(&(bar)[XB_TMO], 1u); break; } } } } while (0)
struct XcdBarrier { unsigned* bar; unsigned x; volatile LAS unsigned* st; };
__device__ __forceinline__ XcdBarrier xcd_barrier_post(unsigned* bar, volatile LAS unsigned* st) {
    XcdBarrier b; b.bar = bar; b.x = xb_xcc_id(); b.st = st;
    if (threadIdx.x == 0) (void)xb_add(&bar[XB_XCNT(b.x)], 1u);
    return b;
}
__device__ __forceinline__ void xcd_barrier_complete(unsigned* bar, unsigned x, unsigned& nloc, unsigned& nx) {
    const unsigned G = gridDim.x * gridDim.y * gridDim.z;
    unsigned sum, cnt, mine, sp = 0u;
    for (;;) {
        sum = 0u; cnt = 0u; mine = 0u;
#pragma unroll
        for (unsigned j = 0; j < 16; ++j) { const unsigned c = xb_ld(&bar[XB_XCNT(j)]); sum += c; cnt += (c > 0u) ? 1u : 0u; mine = (j == x) ? c : mine; }
        if (sum == G) break;
        __builtin_amdgcn_s_sleep(1);
        if ((++sp & 255u) == 0u) { if (xb_ld(&bar[XB_TMO])) break; if (sp > XB_SPIN_CAP) { atomicAdd(&bar[XB_TMO], 1u); break; } }
    }
    nloc = mine > 0u ? mine : 1u; nx = cnt > 0u ? cnt : 1u;
}
__device__ __forceinline__ void xcd_barrier(const XcdBarrier& b) {
    asm volatile("s_waitcnt vmcnt(0)" ::: "memory");
    __syncthreads();
    if (threadIdx.x == 0) {
        unsigned* bar = b.bar;
        __builtin_amdgcn_s_waitcnt(0);
        unsigned nloc = b.st[0], nx = b.st[1];
        if (nloc == 0u) { xcd_barrier_complete(bar, b.x, nloc, nx); b.st[0] = nloc; b.st[1] = nx; }
        const unsigned old = xb_add(&bar[XB_XSUB(b.x)], 1u);
        const unsigned gen = old / nloc;
        if (old + 1u == (gen + 1u) * nloc) {
            __builtin_amdgcn_fence(__ATOMIC_RELEASE, "agent");
            asm volatile("s_waitcnt vmcnt(0)" ::: "memory");
            const unsigned og = xb_add(&bar[XB_TOP], 1u);
            const unsigned tg = og / nx;
            if (og + 1u == (tg + 1u) * nx) xb_add(&bar[XB_TOPGEN], 1u);
            else XB_SPIN(xb_ld(&bar[XB_TOPGEN]) == tg, bar);
            __builtin_amdgcn_fence(__ATOMIC_ACQUIRE, "agent");
            xb_add(&bar[XB_XGEN(b.x)], 1u);
            asm volatile("s_waitcnt vmcnt(0)" ::: "memory");
        } else {
            XB_SPIN(xb_ld(&bar[XB_XGEN(b.x)]) == gen, bar);
            __builtin_amdgcn_fence(__ATOMIC_ACQUIRE, "agent");
            asm volatile("s_waitcnt vmcnt(0)" ::: "memory");
        }
    }
    __syncthreads();
}

struct Args {
    const float* in[20]; float* out; unsigned char* ws; int ph_lo, ph_hi;
};

__device__ __forceinline__ int map_in(int c) {
    if (c < 256) return PC_QG + c; if (c < 512) return PC_KG + c - 256; if (c < 1024) return PC_VG + c - 512; if (c < 1536) return PC_GG + c - 1024;
    if (c < 1552) return 3072 + c - 1536; if (c < 2064) return PC_QF + c - 1552; if (c < 2576) return PC_KF + c - 2064; if (c < 3088) return PC_VF + c - 2576;
    return 3088 + c - 3088;
}
__device__ __forceinline__ int map_e1(int c) { return ((c & 1023) >> 7) * 256 + (c >> 10) * 128 + (c & 127); }
struct TrItem { const float* W; unsigned char* WT; int N, kbp, nb, map, fp8; };
typedef float tr_f32x4 __attribute__((ext_vector_type(4)));
__device__ __forceinline__ TrItem tr_decode(int it, const Args& args, bf16_t* WINT, bf16_t* WOT, unsigned char* W1F, unsigned char* W2F) {
    constexpr int I_IN = 8 * 97, I_O = 8 * 32, I_E1 = 8 * 64, I_E2 = 8 * 32;
    TrItem d; int r = it;
    if (r < I_IN) { d.W = args.in[6]; d.WT = (unsigned char*)WINT; d.N = 3096; d.kbp = r / 97; d.nb = r % 97; d.map = 1; d.fp8 = 0; return d; } r -= I_IN;
    if (r < I_O) { d.W = args.in[11]; d.WT = (unsigned char*)WOT; d.N = 1024; d.kbp = r / 32; d.nb = r % 32; d.map = 0; d.fp8 = 0; return d; } r -= I_O;
    if (r < NE * I_E1) { const int e = r / I_E1, q = r % I_E1; d.W = args.in[16] + (size_t)e * 1024 * 2048; d.WT = W1F + (size_t)e * 2048 * 1024; d.N = 2048; d.kbp = q / 64; d.nb = q % 64; d.map = 2; d.fp8 = 1; return d; } r -= NE * I_E1;
    { const int e = r / I_E2, q = r % I_E2; d.W = args.in[18] + (size_t)e * 1024 * 1024; d.WT = W2F + (size_t)e * 1024 * 1024; d.N = 1024; d.kbp = q / 32; d.nb = q % 32; d.map = 0; d.fp8 = 1; return d; }
}
constexpr int TR_NITEMS = 8 * 97 + 8 * 32 + NE * 8 * 64 + NE * 8 * 32;
__device__ __forceinline__ void tr_load(tr_f32x4 (&v)[8], const TrItem& d, int sub, int lane) {
    const int k0 = 64 * (2 * d.kbp + sub), n = 32 * d.nb + (lane & 7) * 4, kr = lane >> 3; const bool ok = n < d.N;
#pragma unroll
    for (int i = 0; i < 8; ++i) v[i] = ok ? __builtin_nontemporal_load((const tr_f32x4*)(d.W + (size_t)(k0 + 8 * kr + i) * d.N + n)) : (tr_f32x4){0.f, 0.f, 0.f, 0.f};
    asm volatile("" ::: "memory");
}
__device__ __forceinline__ void tr_process(const tr_f32x4 (&v)[8], const TrItem& d, int sub, LAS float* scr, int lane) {
    (void)scr;
    const int k0 = 64 * (2 * d.kbp + sub), n0 = 32 * d.nb + (lane & 7) * 4, kr = lane >> 3;
#pragma unroll
    for (int c = 0; c < 4; ++c) { const int col = n0 + c;
        const int drow = col < d.N ? (d.map == 0 ? col : (d.map == 1 ? map_in(col) : map_e1(col))) : 4096;
        if (drow < 3072) {
            if (d.fp8) { uint2 o; o.x = pk4_fp8(v[0][c] * WSCALE, v[1][c] * WSCALE, v[2][c] * WSCALE, v[3][c] * WSCALE); o.y = pk4_fp8(v[4][c] * WSCALE, v[5][c] * WSCALE, v[6][c] * WSCALE, v[7][c] * WSCALE);
                *(uint2*)(d.WT + (size_t)drow * 1024 + k0 + 8 * kr) = o; }
            else { uint4 o; o.x = pk2(v[0][c], v[1][c]); o.y = pk2(v[2][c], v[3][c]); o.z = pk2(v[4][c], v[5][c]); o.w = pk2(v[6][c], v[7][c]);
                *(uint4*)((bf16_t*)d.WT + (size_t)drow * 1024 + k0 + 8 * kr) = o; } } }
}

__global__ void __launch_bounds__(NTHR, 2) mk_fwd(Args args) {
    extern __shared__ __attribute__((aligned(16))) unsigned char lds_raw[];
    LAS unsigned char* lds = (LAS unsigned char*)lds_raw;
    const int tid = threadIdx.x, lane = tid & 63, wave = __builtin_amdgcn_readfirstlane(tid >> 6);
    const int G = gridDim.x, bx = blockIdx.x;
    const int vcu = (G % 8 == 0) ? (bx % 8) * (G / 8) + bx / 8 : bx;
    unsigned char* ws = args.ws;
    int* ctl = (int*)(ws + WS_CTL);
    float* mod = (float*)(ws + WS_MOD);
    bf16_t* XN = (bf16_t*)(ws + WS_XN); bf16_t* PROJ = (bf16_t*)(ws + WS_PROJ); bf16_t* AO = (bf16_t*)(ws + WS_AO); float* Y = (float*)(ws + WS_Y);
    bf16_t* ACT = (bf16_t*)(ws + WS_ACT); bf16_t* YS = (bf16_t*)(ws + WS_YS); float* ZF = (float*)(ws + WS_ZF);
    bf16_t* WINT = (bf16_t*)(ws + WS_WINT); bf16_t* WOT = (bf16_t*)(ws + WS_WOT); bf16_t* W1T = (bf16_t*)(ws + WS_W1T); bf16_t* W2T = (bf16_t*)(ws + WS_W2T);
    const int lo = args.ph_lo, hi = args.ph_hi;
#define IN(k) (lo <= (k) && (k) < hi)
#define SEAM(k) do { if (IN(k) && IN((k) + 1)) xcd_barrier(bar); } while (0)
    { int u0 = tid; asm volatile("" : "+v"(u0));
      for (int u = u0; u < (LDS_BYTES - LDSCTL_OFF) / 4; u += NTHR) ((LAS unsigned*)(lds + LDSCTL_OFF))[u] = 0u; }
    __syncthreads();
    XcdBarrier bar; bar.bar = (unsigned*)ctl + CW_BAR; bar.x = 0; bar.st = nullptr;
    if (hi - lo > 1) bar = xcd_barrier_post((unsigned*)ctl + CW_BAR, (volatile LAS unsigned*)(lds + MISC_OFF) + 8);
    const int gw = vcu * NWAVES + wave, NGW = G * NWAVES;

    if (IN(PH_PRO)) {
        const float* c = args.in[1]; const float* w_ada = args.in[2]; const float* b_ada = args.in[3];
        typedef float f32x4 __attribute__((ext_vector_type(4)));
        LAS float* sc = (LAS float*)lds;
        LAS float* red = (LAS float*)(lds + 16384);
        { int i0 = tid; asm volatile("" : "+v"(i0)); for (int i = i0; i < 4096; i += NTHR) sc[i] = silu_f(c[i]); }
        __syncthreads();
        { const int kk = tid / 6, c4 = tid % 6, n0 = bx * 24;
          f32x4 wv[13];
#pragma unroll
          for (int j = 0; j < 13; ++j) { const int k = kk + 85 * j; wv[j] = (tid < 510 && k < 1024) ? __builtin_nontemporal_load((const f32x4*)(w_ada + (size_t)k * 6144 + n0 + 4 * c4)) : (f32x4){0.f, 0.f, 0.f, 0.f}; }
          f32x4 a0 = (f32x4){0.f, 0.f, 0.f, 0.f}, a1 = a0, a2 = a0, a3 = a0;
#pragma unroll
          for (int j = 0; j < 13; ++j) { const int k = kk + 85 * j; if (k < 1024) { a0 += wv[j] * sc[k]; a1 += wv[j] * sc[1024 + k]; a2 += wv[j] * sc[2048 + k]; a3 += wv[j] * sc[3072 + k]; } }
          if (tid < 510) { LAS float* rp = red + kk * 96 + 4 * c4; *(LAS f32x4*)(rp) = a0; *(LAS f32x4*)(rp + 24) = a1; *(LAS f32x4*)(rp + 48) = a2; *(LAS f32x4*)(rp + 72) = a3; } }
        __syncthreads();
        if (tid < 96) { const int b = tid / 24, nl = tid % 24, n = bx * 24 + nl; float s = b_ada[n];
            for (int kk = 0; kk < 85; ++kk) s += red[kk * 96 + b * 24 + nl];
            mod[b * 6144 + n] = s; }
        __syncthreads();
        { LAS float* scr = (LAS float*)(lds + wave * 16384);
          unsigned char* W1F = (unsigned char*)W1T; unsigned char* W2F = (unsigned char*)W2T;
          tr_f32x4 vA[8], vB[8];
          int it = gw;
          if (it < TR_NITEMS) {
              TrItem d = tr_decode(it, args, WINT, WOT, W1F, W2F);
              tr_load(vA, d, 0, lane);
#pragma unroll 1
              for (;;) {
                  tr_load(vB, d, 1, lane);
                  tr_process(vA, d, 0, scr, lane);
                  const int itn = it + NGW; const bool more = itn < TR_NITEMS;
                  const TrItem dn = tr_decode(more ? itn : it, args, WINT, WOT, W1F, W2F);
                  if (more) tr_load(vA, dn, 0, lane);
                  tr_process(vB, d, 1, scr, lane);
                  if (!more) break;
                  it = itn; d = dn;
              } } }
    }
    SEAM(PH_PRO);
    if (IN(PH_XN)) {
        typedef float f32x4 __attribute__((ext_vector_type(4)));
        const float* x = args.in[0]; const float* gain = args.in[4]; const float* w_in = args.in[6];
        constexpr int HTS = 1028;
        LAS float* HT = (LAS float*)lds; LAS float* PART = (LAS float*)(lds + 65792);
        LAS float* PA = (LAS float*)(lds + 82432); LAS float* PB = PA + 1024;
        { const int b0 = (128 * bx) / S; const float* md = mod + b0 * 6144;
          int c0 = tid; asm volatile("" : "+v"(c0)); for (int c = c0; c < 1024; c += NTHR) { PA[c] = gain[c] * (1.f + md[1024 + c]); PB[c] = md[c]; } }
        __syncthreads();
        const int fr = lane & 15, fq = lane >> 4;
        float bw[32][2];
#pragma unroll
        for (int s2 = 0; s2 < 32; ++s2) { const size_t kr = (size_t)(128 * wave + 4 * s2 + fq) * 3096;
            bw[s2][0] = w_in[kr + 1536 + fr]; bw[s2][1] = fr < 8 ? w_in[kr + 3088 + fr] : 0.f; }
#define XN_LOAD(RX, p) do { _Pragma("unroll") for (int rr = 0; rr < 2; ++rr) { const int row_ = 128 * bx + 16 * (p) + 2 * wave + rr; \
            _Pragma("unroll") for (int j = 0; j < 4; ++j) { const f32x4 t_ = __builtin_nontemporal_load((const f32x4*)(x + (size_t)row_ * D) + lane + 64 * j); RX[rr][j] = make_float4(t_[0], t_[1], t_[2], t_[3]); } } asm volatile("" ::: "memory"); } while (0)
#define XN_PASS(RX, p) do { \
            _Pragma("unroll") for (int rr = 0; rr < 2; ++rr) { \
                const int rowl = 2 * wave + rr, row = 128 * bx + 16 * (p) + rowl; \
                float ss = 0.f; \
                _Pragma("unroll") for (int j = 0; j < 4; ++j) { const float4 v_ = RX[rr][j]; ss += v_.x * v_.x + v_.y * v_.y + v_.z * v_.z + v_.w * v_.w; } \
                const float rstd = rsqrtf(wave_sum(ss) * (1.f / D) + EPS); \
                _Pragma("unroll") for (int j = 0; j < 4; ++j) { const int col = 4 * lane + 256 * j; const float4 v_ = RX[rr][j]; \
                    const f32x4 pa = *(LAS const f32x4*)(PA + col), pb = *(LAS const f32x4*)(PB + col); \
                    f32x4 hv; hv[0] = v_.x * rstd * pa[0] + pb[0]; hv[1] = v_.y * rstd * pa[1] + pb[1]; \
                    hv[2] = v_.z * rstd * pa[2] + pb[2]; hv[3] = v_.w * rstd * pa[3] + pb[3]; \
                    uint2 w; w.x = pk2(hv[0], hv[1]); w.y = pk2(hv[2], hv[3]); \
                    *(uint2*)(XN + (size_t)row * D + col) = w; \
                    *(LAS f32x4*)(HT + rowl * HTS + col) = hv; } \
            } \
            __syncthreads(); \
            { f32x4 a0 = (f32x4){0.f, 0.f, 0.f, 0.f}, a1 = (f32x4){0.f, 0.f, 0.f, 0.f}; \
              float av[32]; \
              _Pragma("unroll") for (int s2 = 0; s2 < 32; ++s2) av[s2] = HT[fr * HTS + 128 * wave + 4 * s2 + fq]; \
              asm volatile("s_waitcnt lgkmcnt(0)" ::: "memory"); __builtin_amdgcn_sched_barrier(0); \
              _Pragma("unroll") for (int s2 = 0; s2 < 32; ++s2) { \
                  a0 = __builtin_amdgcn_mfma_f32_16x16x4f32(av[s2], bw[s2][0], a0, 0, 0, 0); a1 = __builtin_amdgcn_mfma_f32_16x16x4f32(av[s2], bw[s2][1], a1, 0, 0, 0); } \
              _Pragma("unroll") for (int r = 0; r < 4; ++r) { PART[(wave * 16 + 4 * fq + r) * 32 + fr] = a0[r]; PART[(wave * 16 + 4 * fq + r) * 32 + 16 + fr] = a1[r]; } } \
            __syncthreads(); \
            { const int rowl = tid >> 5, n = tid & 31; float sum = 0.f; \
              _Pragma("unroll") for (int w2 = 0; w2 < 8; ++w2) sum += PART[(w2 * 16 + rowl) * 32 + n]; \
              unsigned zo = (unsigned)(128 * bx + 16 * (p) + rowl) * 32u + n; asm volatile("" : "+v"(zo)); ZF[zo] = sum; } \
        } while (0)
        { float4 xA[2][4], xB[2][4], xC[2][4];
          XN_LOAD(xA, 0); XN_LOAD(xB, 1);
          XN_LOAD(xC, 2); XN_PASS(xA, 0);
          XN_LOAD(xA, 3); XN_PASS(xB, 1);
          XN_LOAD(xB, 4); XN_PASS(xC, 2);
          XN_LOAD(xC, 5); XN_PASS(xA, 3);
          XN_LOAD(xA, 6); XN_PASS(xB, 4);
          XN_LOAD(xB, 7); XN_PASS(xC, 5);
          XN_PASS(xA, 6);
          XN_PASS(xB, 7); }
#undef XN_LOAD
#undef XN_PASS
    }
    SEAM(PH_XN);
    if (IN(PH_G1)) {
        pg8::Gemm g{XN, WINT, 1024, 0, nullptr}; pg8::Order O; O.init(M / 256, NPROJ / 256, G, bx, (const LAS int*)nullptr);
        pg8::EpiProj E{PROJ, ZF};
        pg8::gemm_phase<pg8::EpiProj, 0, false>(lds, g, O, E);
    }
    SEAM(PH_G1);
    float* KV = (float*)(ws + WS_KV); bf16_t* SP = (bf16_t*)(ws + WS_SP); float* DEC = (float*)(ws + WS_DEC); float* LF = (float*)(ws + WS_LF); float* SEGT = (float*)(ws + WS_SEGT);
    float* NF = (float*)(ws + WS_NF);
    if (IN(PH_GLAA)) {
        { const int bhf = bx >> 3, seg = bx & 7, b = bhf >> 3, hf = bhf & 7; const float bfv = args.in[10][hf];
          const int t0 = seg * 1024 + 2 * tid;
          const float l0 = logsigmoid_f(ZF[((size_t)b * S + t0) * 32 + 16 + hf] + bfv), l1 = logsigmoid_f(ZF[((size_t)b * S + t0 + 1) * 32 + 16 + hf] + bfv);
          const float c1 = l0 + l1; float sc = c1;
#pragma unroll
          for (int off = 1; off < 64; off <<= 1) { const float t = __shfl_up(sc, off); if (lane >= off) sc += t; }
          LAS float* wt = (LAS float*)(lds + gla::L_END);
          if (lane == 63) wt[wave] = sc;
          __syncthreads();
          float base = 0.f, total = 0.f;
#pragma unroll
          for (int w = 0; w < 8; ++w) { const float t = wt[w]; total += t; if (w < wave) base += t; }
          const float excl = base + sc - c1;
          LF[(size_t)bhf * S + t0] = excl + l0; LF[(size_t)bhf * S + t0 + 1] = excl + c1;
          if (tid == 0) SEGT[bhf * 8 + seg] = total;
          __syncthreads(); }
        gla::run_units<false>(lds, bx * 8, 8, PROJ, ZF, args.in[7], args.in[8], nullptr, nullptr, KV, DEC, nullptr);
    }
    SEAM(PH_GLAA);
    if (IN(PH_SCAN)) {
        { const int gid = bx * NTHR + tid, bh = gid >> 13, k = (gid >> 7) & 63, v = gid & 127;
          const bf16_t* kvp = (const bf16_t*)KV + (size_t)bh * 128 * 8192 + k * 128 + v; const float* dp = DEC + (size_t)bh * 128 * 64 + k; bf16_t* sp = SP + (size_t)bh * 128 * 8192 + k * 128 + v;
          float s = 0.f;
          for (int n0 = 0; n0 < 128; n0 += 8) { float kvv[8], dd[8];
#pragma unroll
              for (int u = 0; u < 8; ++u) { kvv[u] = bf2f(__builtin_nontemporal_load(kvp + (size_t)(n0 + u) * 8192)); dd[u] = dp[(n0 + u) * 64]; }
#pragma unroll
              for (int u = 0; u < 8; ++u) { sp[(size_t)(n0 + u) * 8192] = (bf16_t)f2bf(s); s = dd[u] * s + kvv[u]; } } }
        { const int bhf = bx >> 3, seg = bx & 7, b = bhf >> 3, hf = bhf & 7; float q2m = 0.f, k2m = 0.f, dmin = 3.0e38f;
#pragma unroll 1
          for (int u = 0; u < 2; ++u) { const size_t row = (size_t)b * S + seg * 1024 + 2 * tid + u; float q2 = 0.f, k2 = 0.f, dg = 0.f;
#pragma unroll
              for (int c8 = 0; c8 < 8; ++c8) { const uint4 qa = *(const uint4*)(PROJ + row * NPROJ + PC_QF + hf * 64 + c8 * 8), ka = *(const uint4*)(PROJ + row * NPROJ + PC_KF + hf * 64 + c8 * 8);
                  const unsigned qw[4] = {qa.x, qa.y, qa.z, qa.w}, kw[4] = {ka.x, ka.y, ka.z, ka.w};
#pragma unroll
                  for (int i = 0; i < 4; ++i) { const float q0 = bf2f(qw[i] & 0xffffu), q1 = bf2f(qw[i] >> 16), k0 = bf2f(kw[i] & 0xffffu), k1 = bf2f(kw[i] >> 16); q2 += q0 * q0 + q1 * q1; k2 += k0 * k0 + k1 * k1; dg += q0 * k0 + q1 * k1; } }
              q2m = fmaxf(q2m, q2); k2m = fmaxf(k2m, k2); dmin = fminf(dmin, dg); }
#pragma unroll
          for (int o = 1; o < 64; o <<= 1) { q2m = fmaxf(q2m, __shfl_xor(q2m, o)); k2m = fmaxf(k2m, __shfl_xor(k2m, o)); dmin = fminf(dmin, __shfl_xor(dmin, o)); }
          LAS float* dml = (LAS float*)lds; if (lane == 0) dml[wave] = dmin;
          __syncthreads();
          if (tid < 4) ((float*)(ws + WS_UDMIN))[bhf * 32 + seg * 4 + tid] = fminf(dml[2 * tid], dml[2 * tid + 1]);
          if (lane == 0) { atomicMax((unsigned*)ctl + CW_QK2 + bhf, __float_as_uint(q2m)); atomicMax((unsigned*)ctl + CW_QK2 + 32 + bhf, __float_as_uint(k2m)); } }
        for (int idx = bx * NTHR + tid; idx < 32 * S; idx += G * NTHR) { const int bhf = idx >> 13, seg = (idx & 8191) >> 10; float base = 0.f;
            for (int s2 = 0; s2 < seg; ++s2) base += SEGT[bhf * 8 + s2];
            NF[idx] = -(LF[idx] + base) * LOG2E; }
    }
    SEAM(PH_SCAN);
    if (IN(PH_ATTN)) {
        static_assert(attn_body::ATTN_LDS_BYTES <= RING_BYTES, "attention LDS");
        const attn_body::AttnTensors AT{(const attn_body::bf16*)(PROJ + PC_QF), (const attn_body::bf16*)(PROJ + PC_KF), (const attn_body::bf16*)(PROJ + PC_VF), (attn_body::bf16*)(AO + 512), (const float*)(ws + WS_NF), (const float*)(ws + WS_UDMIN), (const unsigned*)ctl + CW_QK2};
        static_assert(attn_body::ATT_TAB + 512 + 4096 <= RING_BYTES, "attention tables");
        attn_body::attn_phase_queue<8>((char*)lds_raw, AT, (unsigned*)ctl + CW_AQ);
        __syncthreads();
        gla::run_pairs_c(lds, LDS_BYTES - 8192, bx * 8, 8, PROJ, ZF, args.in[7], args.in[8], SP, args.in[9], AO);
    }
    SEAM(PH_ATTN);
    if (IN(PH_WO)) {
        pg8::Gemm g{AO, WOT, 1024, 0, nullptr}; pg8::Order O; O.init(M / 256, 4, G, bx, (const LAS int*)nullptr);
        pg8::EpiBf16 E{(bf16_t*)Y, D};
        pg8::gemm_phase<pg8::EpiBf16, 0, false>(lds, g, O, E);
    }
    SEAM(PH_WO);
    int* TOPE = (int*)(ws + WS_TOPE); float* TOPG = (float*)(ws + WS_TOPG); int* RANK = (int*)(ws + WS_RANK); int* TPOS = (int*)(ws + WS_TPOS); int* SLOT = (int*)(ws + WS_SLOT);
    int* SLOTE = (int*)(ws + WS_SLOTE);
    if (IN(PH_ROUTE)) {
        typedef float f32x4 __attribute__((ext_vector_type(4)));
        const float* x = args.in[0]; const float* g_post = args.in[5]; const float* g_mpre = args.in[12]; const float* w_router = args.in[14]; const float* b_router = args.in[15];
        bf16_t* X1B = (bf16_t*)(ws + WS_X1B);
        constexpr int HTS = 1028;
        LAS float* HT = (LAS float*)lds; LAS float* PART = (LAS float*)(lds + 65792); LAS int* lcnt = (LAS int*)(lds + 82176);
        LAS int* er_l = (LAS int*)(lds + 98304); LAS int* lbase = er_l + 512;
        if (tid < 32) lcnt[tid] = 0;
        LAS float* PA = (LAS float*)(lds + 82432); LAS float* PB = PA + 1024; LAS float* PC = PB + 1024;
        { const int b0 = (128 * bx) / S; const float* md = mod + b0 * 6144;
          int c0 = tid; asm volatile("" : "+v"(c0)); for (int c = c0; c < 1024; c += NTHR) { PA[c] = md[2048 + c] * g_post[c]; PB[c] = g_mpre[c] * (1.f + md[4096 + c]); PC[c] = md[3072 + c]; } }
        unsigned char* H2F = (unsigned char*)XN;
        if (bx == 0 && tid < 256) ((unsigned*)(H2F + (size_t)M * D))[tid] = 0u;
        const int fr = lane & 15, fq = lane >> 4;
        float bw[32][2];
#pragma unroll
        for (int s = 0; s < 32; ++s)
#pragma unroll
            for (int nt = 0; nt < 2; ++nt) bw[s][nt] = w_router[(size_t)(128 * wave + 4 * s + fq) * 32 + 16 * nt + fr];
        __syncthreads();
#define ROUTE_LOAD(RX, RY, p) do { _Pragma("unroll") for (int rr = 0; rr < 2; ++rr) { const int row_ = 128 * bx + 16 * (p) + 2 * wave + rr; \
            _Pragma("unroll") for (int j = 0; j < 4; ++j) { RY[rr][j] = ((const uint2*)((const bf16_t*)Y + (size_t)row_ * D))[lane + 64 * j]; { const f32x4 t_ = __builtin_nontemporal_load((const f32x4*)(x + (size_t)row_ * D) + lane + 64 * j); RX[rr][j] = make_float4(t_[0], t_[1], t_[2], t_[3]); } } } \
            asm volatile("" ::: "memory"); } while (0)
#define ROUTE_PASS(RX, RY, p) do { \
            _Pragma("unroll") for (int rr = 0; rr < 2; ++rr) { \
                const int rowl = 2 * wave + rr, row = 128 * bx + 16 * (p) + rowl; \
                float4 yv[4], xv[4]; float ss = 0.f; \
                _Pragma("unroll") for (int j = 0; j < 4; ++j) { const uint2 yr = RY[rr][j]; yv[j] = make_float4(bf2f(yr.x & 0xffffu), bf2f(yr.x >> 16), bf2f(yr.y & 0xffffu), bf2f(yr.y >> 16)); xv[j] = RX[rr][j]; \
                    ss += yv[j].x * yv[j].x + yv[j].y * yv[j].y + yv[j].z * yv[j].z + yv[j].w * yv[j].w; } \
                const float rstd_y = rsqrtf(wave_sum(ss) * (1.f / D) + EPS); \
                float s1 = 0.f; \
                _Pragma("unroll") for (int j = 0; j < 4; ++j) { const int col = 4 * lane + 256 * j; const f32x4 pa = *(LAS const f32x4*)(PA + col); \
                    xv[j].x += pa[0] * yv[j].x * rstd_y; xv[j].y += pa[1] * yv[j].y * rstd_y; xv[j].z += pa[2] * yv[j].z * rstd_y; xv[j].w += pa[3] * yv[j].w * rstd_y; \
                    { uint2 xw_; xw_.x = pk2(xv[j].x, xv[j].y); xw_.y = pk2(xv[j].z, xv[j].w); ((uint2*)(X1B + (size_t)row * D))[lane + 64 * j] = xw_; } \
                    s1 += xv[j].x * xv[j].x + xv[j].y * xv[j].y + xv[j].z * xv[j].z + xv[j].w * xv[j].w; } \
                const float rstd1 = rsqrtf(wave_sum(s1) * (1.f / D) + EPS); \
                _Pragma("unroll") for (int j = 0; j < 4; ++j) { const int col = 4 * lane + 256 * j; const f32x4 pb = *(LAS const f32x4*)(PB + col), pc = *(LAS const f32x4*)(PC + col); \
                    f32x4 hv; \
                    hv[0] = xv[j].x * rstd1 * pb[0] + pc[0]; hv[1] = xv[j].y * rstd1 * pb[1] + pc[1]; \
                    hv[2] = xv[j].z * rstd1 * pb[2] + pc[2]; hv[3] = xv[j].w * rstd1 * pb[3] + pc[3]; \
                    *(unsigned*)(H2F + (size_t)row * D + col) = pk4_fp8(hv[0], hv[1], hv[2], hv[3]); \
                    *(LAS f32x4*)(HT + rowl * HTS + col) = hv; } \
            } \
            __syncthreads(); \
            { f32x4 a0 = (f32x4){0.f, 0.f, 0.f, 0.f}, a1 = (f32x4){0.f, 0.f, 0.f, 0.f}; \
              float av[32]; \
              _Pragma("unroll") for (int s = 0; s < 32; ++s) av[s] = HT[fr * HTS + 128 * wave + 4 * s + fq]; \
              asm volatile("s_waitcnt lgkmcnt(0)" ::: "memory"); __builtin_amdgcn_sched_barrier(0);     \
              _Pragma("unroll") for (int s = 0; s < 32; ++s) { \
                  a0 = __builtin_amdgcn_mfma_f32_16x16x4f32(av[s], bw[s][0], a0, 0, 0, 0); a1 = __builtin_amdgcn_mfma_f32_16x16x4f32(av[s], bw[s][1], a1, 0, 0, 0); } \
              _Pragma("unroll") for (int r = 0; r < 4; ++r) { PART[(wave * 16 + 4 * fq + r) * 32 + fr] = a0[r]; PART[(wave * 16 + 4 * fq + r) * 32 + 16 + fr] = a1[r]; } } \
            __syncthreads(); \
            { const int rr = lane >> 5, e = lane & 31, rowl = 2 * wave + rr, row = 128 * bx + 16 * (p) + rowl; \
              float mine = b_router[e]; \
              _Pragma("unroll") for (int w2 = 0; w2 < 8; ++w2) mine += PART[(w2 * 16 + rowl) * 32 + e]; \
              float my_v = -INFINITY, v0 = 0.f; int my_e = 0; \
              _Pragma("unroll") for (int r = 0; r < 4; ++r) { float bv = mine; int bi = e; \
                  ARGMAX_DPP(0xB1, bv, bi); ARGMAX_DPP(0x4E, bv, bi); ARGMAX_DPP(0x141, bv, bi); ARGMAX_DPP(0x140, bv, bi); \
                  { const float ov = __shfl_xor(bv, 16); const int oi = __shfl_xor(bi, 16); if (ov > bv || (ov == bv && oi < bi)) { bv = ov; bi = oi; } } \
                  if (r == 0) v0 = bv; \
                  if (e == r) { my_v = bv; my_e = bi; } \
                  if (e == bi) mine = -INFINITY; } \
              const float ex = e < 4 ? __expf(my_v - v0) : 0.f; \
              float gs = ex; gs += dpp_mov_f<0xB1>(gs); gs += dpp_mov_f<0x4E>(gs); \
              if (e < 4) { const int rk = __hip_atomic_fetch_add(lcnt + my_e, 1, __ATOMIC_RELAXED, __HIP_MEMORY_SCOPE_WORKGROUP); \
                  TOPG[row * 4 + e] = ex / gs; er_l[(16 * (p) + rowl) * 4 + e] = my_e | (rk << 8); } } \
        } while (0)
        { float4 xA[2][4]; uint2 yA[2][4];
#pragma unroll 1
          for (int p = 0; p < 8; ++p) { ROUTE_LOAD(xA, yA, p); ROUTE_PASS(xA, yA, p); } }
#undef ROUTE_LOAD
#undef ROUTE_PASS
        __syncthreads();
        if (tid < 32) lbase[tid] = atomicAdd(ctl + CW_CNT + tid, lcnt[tid]);
        __syncthreads();
        { int t1 = tid; asm volatile("" : "+v"(t1)); const int v = er_l[t1], e = v & 255, pos = lbase[e] + (v >> 8), i = bx * NTHR + tid;
          SLOTE[(size_t)e * M + pos] = i >> 2; TPOS[i] = (e << 16) | pos; }
    }
    SEAM(PH_ROUTE);
#define EXPERT_TABLES(WITH_TE) \
        LAS int* te_l = (LAS int*)(lds + LDSCTL_OFF + 1024); LAS int* tb_l = (LAS int*)(lds + LDSCTL_OFF + 6144); LAS int* cn_l = tb_l + 64; \
        if (wave == 0) { const int c_ = lane < NE ? __hip_atomic_load(ctl + CW_CNT + (lane & 31), __ATOMIC_RELAXED, __HIP_MEMORY_SCOPE_AGENT) : 0; const int t_ = (c_ + 255) >> 8; int in_ = t_; \
            _Pragma("unroll") for (int o_ = 1; o_ < 32; o_ <<= 1) { const int u_ = __shfl_up(in_, o_); if (lane >= o_) in_ += u_; } \
            if (lane < NE) { cn_l[lane] = c_; tb_l[lane] = in_ - t_; } if (lane == NE - 1) tb_l[NE] = in_; } \
        __syncthreads(); \
        const int ntiles = __builtin_amdgcn_readfirstlane(tb_l[NE]); \
        if (WITH_TE) { int t0 = tid; asm volatile("" : "+v"(t0));          \
          for (int t = t0; t < ntiles; t += NTHR) { int e_ = 0; _Pragma("unroll") for (int k_ = 1; k_ < NE; ++k_) e_ = tb_l[k_] <= t ? k_ : e_; te_l[t] = e_; } \
          __syncthreads(); }
    if (IN(PH_E1)) {
        EXPERT_TABLES(true)
        pg8::Gemm g{XN, W1T, 1024, (size_t)2048 * 1024, (const int*)(ws + WS_SLOTE), tb_l, cn_l}; pg8::Order O; O.init(ntiles, 8, G, bx, te_l);
        pg8::EpiE1 E{(unsigned char*)ACT, args.in[17]};
        pg8::gemm_phase<pg8::EpiE1, 1, true>(lds, g, O, E);
    }
    SEAM(PH_E1);
    if (IN(PH_E2)) {
        EXPERT_TABLES(true)
        pg8::Gemm g{ACT, W2T, 1024, (size_t)1024 * 1024, nullptr, nullptr, nullptr}; pg8::Order O; O.init(ntiles, 4, G, bx, te_l);
        pg8::EpiE2 E{(unsigned char*)YS, args.in[19]};
        pg8::gemm_phase<pg8::EpiE2, 2, true>(lds, g, O, E);
    }
    SEAM(PH_E2);
    if (IN(PH_FINAL)) {
        typedef float f32x4 __attribute__((ext_vector_type(4)));
        const float* g_mpost = args.in[13]; float* outp = args.out;
        LAS float* PM = (LAS float*)lds;
        { int c0 = tid; asm volatile("" : "+v"(c0));
          for (int c = c0; c < 4096; c += NTHR) PM[c] = mod[(c >> 10) * 6144 + 5120 + (c & 1023)] * g_mpost[c & 1023]; }
        EXPERT_TABLES(false)
        int row = gw;
        int pos_n[4]; float g_n[4];
#pragma unroll
        for (int k = 0; k < 4; ++k) { pos_n[k] = TPOS[row * 4 + k]; g_n[k] = TOPG[row * 4 + k]; }
#pragma unroll 1
        for (; row < M; row += NGW) {
            const int b = row / S;
            unsigned raw[4][4]; float4 o[4]; float gk[4];
#pragma unroll
            for (int k = 0; k < 4; ++k) { gk[k] = g_n[k]; const int pp = tb_l[pos_n[k] >> 16] * 256 + (pos_n[k] & 0xffff);
#pragma unroll
                for (int j = 0; j < 4; ++j) raw[k][j] = __builtin_nontemporal_load((const unsigned*)((const unsigned char*)YS + (size_t)pp * 1024 + 4 * lane + 256 * j)); }
#pragma unroll
            for (int j = 0; j < 4; ++j) { const uint2 xr_ = __builtin_bit_cast(uint2, __builtin_nontemporal_load((const unsigned long long*)((const bf16_t*)(ws + WS_X1B) + (size_t)row * D) + lane + 64 * j)); o[j] = make_float4(bf2f(xr_.x & 0xffffu), bf2f(xr_.x >> 16), bf2f(xr_.y & 0xffffu), bf2f(xr_.y >> 16)); }
            { const int rn = row + NGW < M ? row + NGW : row;
#pragma unroll
              for (int k = 0; k < 4; ++k) { pos_n[k] = TPOS[rn * 4 + k]; g_n[k] = TOPG[rn * 4 + k]; } }
            asm volatile("" ::: "memory");
            float y[16];
#pragma unroll
            for (int i = 0; i < 16; ++i) y[i] = 0.f;
#pragma unroll
            for (int k = 0; k < 4; ++k)
#pragma unroll
                for (int j = 0; j < 4; ++j) { const fp8x2_f32 lo2 = __builtin_amdgcn_cvt_pk_f32_fp8((int)raw[k][j], false), hi2 = __builtin_amdgcn_cvt_pk_f32_fp8((int)raw[k][j], true);
                    y[j * 4 + 0] += gk[k] * lo2[0]; y[j * 4 + 1] += gk[k] * lo2[1]; y[j * 4 + 2] += gk[k] * hi2[0]; y[j * 4 + 3] += gk[k] * hi2[1]; }
            float ss = 0.f;
#pragma unroll
            for (int i = 0; i < 16; ++i) ss += y[i] * y[i];
            const float rstd = rsqrtf(wave_sum(ss) * (1.f / D) + EPS);
#pragma unroll
            for (int j = 0; j < 4; ++j) { const int col = 4 * lane + 256 * j; const f32x4 pm = *(LAS const f32x4*)(PM + b * 1024 + col);
                float4 ov = o[j];
                ov.x += pm[0] * y[j * 4 + 0] * rstd; ov.y += pm[1] * y[j * 4 + 1] * rstd; ov.z += pm[2] * y[j * 4 + 2] * rstd; ov.w += pm[3] * y[j * 4 + 3] * rstd;
                ((float4*)(outp + (size_t)row * D))[lane + 64 * j] = ov; }
        }
    }
#undef IN
#undef SEAM
}

static void launch_mk(const Args& a0, int lo, int hi, hipStream_t stream) {
    Args a = a0; a.ph_lo = lo; a.ph_hi = hi;
    hipLaunchKernelGGL(mk_fwd, dim3(256), dim3(NTHR), LDS_BYTES, stream, a);
}
extern "C" void kernel_launch(void* const* d_in, const int* in_sizes, int n_in, void* d_out, int out_size, void* d_ws, size_t ws_size, hipStream_t stream) {
    if (n_in != 20 || out_size != M * D || ws_size < WS_END2) { fprintf(stderr, "kernel_launch: unexpected shapes (n_in %d out %d ws %zu need %zu)\n", n_in, out_size, ws_size, (size_t)WS_END2); return; }
    static bool attr_set = false;
    if (!attr_set) { (void)hipFuncSetAttribute((const void*)mk_fwd, hipFuncAttributeMaxDynamicSharedMemorySize, LDS_BYTES); attr_set = true; }
    const float* x = (const float*)d_in[0];
    const float* g_apost = (const float*)d_in[5]; const float* w_gk2 = (const float*)d_in[7];
    const float* b_gk = (const float*)d_in[8]; const float* gla_gain = (const float*)d_in[9]; const float* b_f = (const float*)d_in[10];
    const float* g_mpre = (const float*)d_in[12]; const float* g_mpost = (const float*)d_in[13]; const float* w_router = (const float*)d_in[14]; const float* b_router = (const float*)d_in[15];
    float* out = (float*)d_out; unsigned char* ws = (unsigned char*)d_ws;
    int* ctl = (int*)(ws + WS_CTL); float* mod = (float*)(ws + WS_MOD); float* ZF = (float*)(ws + WS_ZF); float* NF = (float*)(ws + WS_NF);
    int* TOPE = (int*)(ws + WS_TOPE); float* TOPG = (float*)(ws + WS_TOPG); int* RANK = (int*)(ws + WS_RANK); int* TPOS = (int*)(ws + WS_TPOS); int* SLOT = (int*)(ws + WS_SLOT);
    bf16_t* XN = (bf16_t*)(ws + WS_XN); bf16_t* PROJ = (bf16_t*)(ws + WS_PROJ); bf16_t* AO = (bf16_t*)(ws + WS_AO); float* Y = (float*)(ws + WS_Y);
    bf16_t* YS = (bf16_t*)(ws + WS_YS);
    Args a{}; for (int i = 0; i < 20; ++i) a.in[i] = (const float*)d_in[i]; a.out = out; a.ws = ws;
    (void)hipMemsetAsync(ws + WS_CTL, 0, 32768, stream);
    launch_mk(a, 0, PH_COUNT, stream);
}
```

```cpp
#include <hip/hip_runtime.h>
#include <cstdio>
#include <cstdint>

typedef unsigned short bf16_t;
constexpr int NB = 4, S = 8192, D = 1024, M = NB * S;
constexpr int NPROJ = 3072;
constexpr int PC_QF = 0, PC_KF = 512, PC_VF = 1024, PC_QG = 1536, PC_KG = 1792, PC_VG = 2048, PC_GG = 2560;
constexpr int NE = 32, TOPK = 4, TK = M * TOPK;
constexpr int MAXTILES = 544, PMAX = MAXTILES * 256;
constexpr float EPS = 1e-6f;
constexpr float LOG2E = 1.4426950408889634f;
constexpr float C2 = 0.125f * LOG2E;
constexpr float WSCALE = 32.f, WSCALE_INV = 1.f / 32.f;

constexpr size_t MiB = 1u << 20;
constexpr size_t WS_CTL = 0;
constexpr size_t WS_MOD = 1 * MiB;
constexpr size_t WS_ZF = 2 * MiB;
constexpr size_t WS_NF = 6 * MiB;
constexpr size_t WS_TOPE = 7 * MiB;
constexpr size_t WS_TOPG = 8 * MiB;
constexpr size_t WS_RANK = 9 * MiB;
constexpr size_t WS_TPOS = 10 * MiB;
constexpr size_t WS_SLOT = 11 * MiB;
constexpr size_t WS_XN = 12 * MiB;
constexpr size_t WS_BIG = 80 * MiB;
constexpr size_t WS_PROJ = WS_BIG;
constexpr size_t WS_AO = WS_PROJ + 208 * MiB;
constexpr size_t WS_Y = WS_AO + 64 * MiB;
constexpr size_t WS_ACT = WS_BIG;
constexpr size_t WS_YS = WS_Y + 128 * MiB;
constexpr size_t WS_END = WS_YS + 272 * MiB;
constexpr size_t WS_X1B = WS_BIG + 140 * MiB;
static_assert(WS_ACT + (size_t)PMAX * 1024 * 2 <= WS_Y, "ACT overlay");
constexpr int CW_CNT = 0;
constexpr int CW_PLAN = 64;
constexpr int CW_TILEE = 128;
constexpr int CW_AQ = 960;
constexpr int CW_QK2 = 1024;

__device__ __forceinline__ float bf2f(unsigned v) { return __uint_as_float(v << 16); }
typedef float hw_f32x2 __attribute__((ext_vector_type(2))); typedef __bf16 hw_bf16x2 __attribute__((ext_vector_type(2)));
__device__ __forceinline__ unsigned pk2(float lo, float hi) { const hw_f32x2 v = {lo, hi}; return __builtin_bit_cast(unsigned, __builtin_convertvector(v, hw_bf16x2)); }
__device__ __forceinline__ unsigned f2bf(float f) { return pk2(f, f) & 0xffffu; }
__device__ __forceinline__ float hi_part(float x) { return __uint_as_float(__float_as_uint(x) & 0xffff0000u); }
__device__ __forceinline__ unsigned pk_hi(float a, float b) { return (__float_as_uint(b) & 0xffff0000u) | (__float_as_uint(a) >> 16); }
__device__ __forceinline__ unsigned pk_lo(float a, float b) { return pk2(a - hi_part(a), b - hi_part(b)); }
__device__ __forceinline__ unsigned pk4_fp8(float a, float b, float c, float d) { int v = __builtin_amdgcn_cvt_pk_fp8_f32(a, b, 0, false); v = __builtin_amdgcn_cvt_pk_fp8_f32(c, d, v, true); return (unsigned)v; }
typedef float fp8x2_f32 __attribute__((ext_vector_type(2)));
template <int CTRL> __device__ __forceinline__ float dpp_mov_f(float x) { return __builtin_bit_cast(float, __builtin_amdgcn_update_dpp(0, __builtin_bit_cast(int, x), CTRL, 0xF, 0xF, true)); }
template <int CTRL> __device__ __forceinline__ int dpp_mov_i(int x) { return __builtin_amdgcn_update_dpp(0, x, CTRL, 0xF, 0xF, true); }
__device__ __forceinline__ float row16_sum(float v) { v += dpp_mov_f<0xB1>(v); v += dpp_mov_f<0x4E>(v); v += dpp_mov_f<0x141>(v); v += dpp_mov_f<0x140>(v); return v; }
__device__ __forceinline__ float wave_sum(float v) {
    v = row16_sum(v);
    const int b = __builtin_bit_cast(int, v);
    return (__builtin_bit_cast(float, __builtin_amdgcn_readlane(b, 0)) + __builtin_bit_cast(float, __builtin_amdgcn_readlane(b, 16))) + (__builtin_bit_cast(float, __builtin_amdgcn_readlane(b, 32)) + __builtin_bit_cast(float, __builtin_amdgcn_readlane(b, 48)));
}
#define ARGMAX_DPP(CTRL, bv, bi) do { const float ov_ = dpp_mov_f<CTRL>(bv); const int oi_ = dpp_mov_i<CTRL>(bi); if (ov_ > bv || (ov_ == bv && oi_ < bi)) { bv = ov_; bi = oi_; } } while (0)
__device__ __forceinline__ float silu_f(float x) { return x / (1.f + __expf(-x)); }
__device__ __forceinline__ float logsigmoid_f(float x) { return fminf(x, 0.f) - log1pf(__expf(-fabsf(x))); }


namespace pg8 {
#define PG8_LAS __attribute__((address_space(3)))
typedef short bf16x8 __attribute__((ext_vector_type(8)));
typedef float f32x4 __attribute__((ext_vector_type(4)));
typedef unsigned u32x4 __attribute__((ext_vector_type(4)));
typedef int i32x4 __attribute__((ext_vector_type(4)));
typedef int i32x8 __attribute__((ext_vector_type(8)));
typedef unsigned u32x2 __attribute__((ext_vector_type(2)));
constexpr int BM = 256, BK = 64, HALF = 128, HTB = HALF * BK * 2, STAGE_BYTES = 8 * HTB, NXCD = 8, WGM = 4;

__host__ __device__ __forceinline__ int lds_byte(int r, int c) { const int st = (r >> 4) * 2 + (c >> 5), rr = r & 15, cc = c & 31, ob = rr * 64 + cc * 2; return st * 1024 + (ob ^ (((ob >> 9) & 1) << 5)); }
__host__ __device__ __forceinline__ void stage_rc(int b, int& R, int& C) { const int st = b / 1024, sb = b % 1024, swz = sb ^ (((sb >> 9) & 1) << 5); R = (st >> 1) * 16 + swz / 64; C = (st & 1) * 32 + (swz % 64) / 2; }
__host__ __device__ __forceinline__ int perm32(int rho) { const int n = rho >> 4, i = rho & 15; return 8 * (i >> 2) + 4 * n + (i & 3); }

struct Unit { int pm, pn, e, seq; };
struct Gemm { const void* A; const void* Bt; int K; size_t estride; const int* rowidx; const PG8_LAS int* tb; const PG8_LAS int* cn; };

struct Order {
    int nM, nN, nwg, G, c; const PG8_LAS int* tile_e;
    __device__ void init(int nM_, int nN_, int G_, int c_, const PG8_LAS int* te) { nM = nM_; nN = nN_; nwg = nM * nN; G = G_; c = c_; tile_e = te; }
    __device__ bool next(int i, Unit& u) const {
        const long L = (long)i * G + c; if (L >= nwg) return false;
        int wgid = (int)L; { const int q = nwg / NXCD, r = nwg % NXCD, xcd = wgid % NXCD, off = wgid / NXCD; wgid = (xcd < r ? xcd * (q + 1) : r * (q + 1) + (xcd - r) * q) + off; }
        const int nig = WGM * nN, gid = wgid / nig, fm = gid * WGM, gsz = (nM - fm) < WGM ? (nM - fm) : WGM;
        u.pm = fm + ((wgid % nig) % gsz); u.pn = (wgid % nig) / gsz;
        u.e = tile_e ? __builtin_amdgcn_readfirstlane(tile_e[u.pm]) : 0; u.seq = i;
        return true;
    }
};

__device__ __forceinline__ unsigned cvt_pk_bf16(float lo, float hi) { unsigned r; asm volatile("v_cvt_pk_bf16_f32 %0, %1, %2" : "=v"(r) : "v"(lo), "v"(hi)); return r; }

struct EpiProj {
    static constexpr bool PERM = true;
    bf16_t* P; float* ZF;
    __device__ __forceinline__ void operator()(const f32x4 (&acc)[2][2][4][2], const Unit& u, int wr, int wc, int fr, int fq) const {
        const int row0 = u.pm * BM + wr * 64 + fr;
        {
            const int col0 = u.pn * BM + wc * 32 + 8 * fq; const float sc = u.pn < 2 ? C2 : 1.f;
#pragma unroll
            for (int ai = 0; ai < 2; ++ai)
#pragma unroll
                for (int m = 0; m < 4; ++m) { bf16_t* rowp = P + (size_t)(row0 + ai * HALF + m * 16) * NPROJ + col0;
#pragma unroll
                    for (int bj = 0; bj < 2; ++bj) { const f32x4 v0 = acc[ai][bj][m][0] * sc, v1 = acc[ai][bj][m][1] * sc; u32x4 w;
                        w.x = cvt_pk_bf16(v0[0], v0[1]); w.y = cvt_pk_bf16(v0[2], v0[3]); w.z = cvt_pk_bf16(v1[0], v1[1]); w.w = cvt_pk_bf16(v1[2], v1[3]);
                        *(u32x4*)(rowp + bj * HALF) = w; } }
        }
    }
};
struct EpiBf16 {
    static constexpr bool PERM = true;
    bf16_t* C; int ldc;
    __device__ __forceinline__ void operator()(const f32x4 (&acc)[2][2][4][2], const Unit& u, int wr, int wc, int fr, int fq) const {
        const int row0 = u.pm * BM + wr * 64 + fr, col0 = u.pn * BM + wc * 32 + 8 * fq;
#pragma unroll
        for (int ai = 0; ai < 2; ++ai)
#pragma unroll
            for (int m = 0; m < 4; ++m) { bf16_t* rowp = C + (size_t)(row0 + ai * HALF + m * 16) * ldc + col0;
#pragma unroll
                for (int bj = 0; bj < 2; ++bj) { const f32x4 v0 = acc[ai][bj][m][0], v1 = acc[ai][bj][m][1]; u32x4 w;
                    w.x = cvt_pk_bf16(v0[0], v0[1]); w.y = cvt_pk_bf16(v0[2], v0[3]); w.z = cvt_pk_bf16(v1[0], v1[1]); w.w = cvt_pk_bf16(v1[2], v1[3]);
                    *(u32x4*)(rowp + bj * HALF) = w; } }
    }
};
struct EpiE1 {
    static constexpr bool PERM = true;
    unsigned char* ACT; const float* b_in;
    const float* w2; unsigned char* W2F; int gwave;
    __device__ __forceinline__ void operator()(const f32x4 (&acc)[2][2][4][2], const Unit& u, int wr, int wc, int fr, int fq) const {
        const int row0 = u.pm * BM + wr * 64 + fr, col0 = u.pn * HALF + wc * 32 + 8 * fq;
        const bool cv = u.seq < 8; f32x4 cvv[8]; const float* cw = w2; unsigned char* co_ = W2F;
        { const int sidx = u.seq * 2048 + gwave, e_ = sidx >> 9, r_ = sidx & 511, q_ = r_ >> 1, sub_ = r_ & 1, k0_ = 64 * (2 * (q_ >> 5) + sub_), ln_ = fr + 16 * fq;
          const int n_ = 32 * (q_ & 31) + (ln_ & 7) * 4, kr_ = ln_ >> 3;
          cw += (size_t)e_ * 1024 * 1024 + (size_t)(k0_ + 8 * kr_) * 1024 + n_; co_ += (size_t)e_ * 1024 * 1024 + (size_t)n_ * 1024 + k0_ + 8 * kr_;
          if (cv) {
#pragma unroll
              for (int i = 0; i < 8; ++i) cvv[i] = __builtin_nontemporal_load((const f32x4*)(cw + (size_t)i * 1024));
              asm volatile("" ::: "memory"); } }
        const float* bg = b_in + (size_t)u.e * 2048 + col0;
        const f32x4 bg0 = *(const f32x4*)(bg), bg1 = *(const f32x4*)(bg + 4), bl0 = *(const f32x4*)(bg + 1024) + 1.f, bl1 = *(const f32x4*)(bg + 1028) + 1.f;
#pragma unroll
        for (int ai = 0; ai < 2; ++ai)
#pragma unroll
            for (int m = 0; m < 4; ++m) { float o[8];
#pragma unroll
                for (int n = 0; n < 2; ++n) { const f32x4 g4 = acc[ai][0][m][n] * WSCALE_INV + (n ? bg1 : bg0), l4 = acc[ai][1][m][n] * WSCALE_INV + (n ? bl1 : bl0);
#pragma unroll
                    for (int i = 0; i < 4; ++i) { const float glu = fminf(g4[i], 7.f), lin1 = __builtin_amdgcn_fmed3f(l4[i], -6.f, 8.f);
                        const float sg = __builtin_amdgcn_rcpf(1.f + __builtin_amdgcn_exp2f(-1.702f * LOG2E * glu));
                        o[n * 4 + i] = glu * sg * lin1; } }
                u32x2 w; w.x = pk4_fp8(o[0], o[1], o[2], o[3]); w.y = pk4_fp8(o[4], o[5], o[6], o[7]);
                *(u32x2*)(ACT + (size_t)(row0 + ai * HALF + m * 16) * 1024 + col0) = w; }
        if (cv) {
#pragma unroll
            for (int c = 0; c < 4; ++c) { u32x2 o;
                o.x = pk4_fp8(cvv[0][c] * WSCALE, cvv[1][c] * WSCALE, cvv[2][c] * WSCALE, cvv[3][c] * WSCALE); o.y = pk4_fp8(cvv[4][c] * WSCALE, cvv[5][c] * WSCALE, cvv[6][c] * WSCALE, cvv[7][c] * WSCALE);
                *(u32x2*)(co_ + (size_t)c * 1024) = o; } }
    }
};
struct EpiE2 {
    static constexpr bool PERM = true;
    unsigned char* YS; const float* b_out;
    __device__ __forceinline__ void operator()(const f32x4 (&acc)[2][2][4][2], const Unit& u, int wr, int wc, int fr, int fq) const {
        const int row0 = u.pm * BM + wr * 64 + fr, col0 = u.pn * BM + wc * 32 + 8 * fq;
        const float* bp = b_out + (size_t)u.e * 1024 + col0;
#pragma unroll
        for (int bj = 0; bj < 2; ++bj) { const f32x4 b0 = *(const f32x4*)(bp + bj * HALF), b1 = *(const f32x4*)(bp + bj * HALF + 4);
#pragma unroll
            for (int ai = 0; ai < 2; ++ai)
#pragma unroll
                for (int m = 0; m < 4; ++m) { const f32x4 v0 = acc[ai][bj][m][0] * WSCALE_INV + b0, v1 = acc[ai][bj][m][1] * WSCALE_INV + b1; u32x2 w;
                    w.x = pk4_fp8(__builtin_amdgcn_fmed3f(v0[0], -448.f, 448.f), __builtin_amdgcn_fmed3f(v0[1], -448.f, 448.f), __builtin_amdgcn_fmed3f(v0[2], -448.f, 448.f), __builtin_amdgcn_fmed3f(v0[3], -448.f, 448.f));
                    w.y = pk4_fp8(__builtin_amdgcn_fmed3f(v1[0], -448.f, 448.f), __builtin_amdgcn_fmed3f(v1[1], -448.f, 448.f), __builtin_amdgcn_fmed3f(v1[2], -448.f, 448.f), __builtin_amdgcn_fmed3f(v1[3], -448.f, 448.f));
                    *(u32x2*)(YS + (size_t)(row0 + ai * HALF + m * 16) * 1024 + col0 + bj * HALF) = w; } }
    }
};

template <class Epi, int AMODE, bool FP8>
__device__ __forceinline__ void gemm_phase(PG8_LAS unsigned char* lds, const Gemm g, const Order& S, const Epi& E) {
    const int tid = threadIdx.x, wid = __builtin_amdgcn_readfirstlane(tid >> 6), lane = tid & 63, wr = wid >> 2, wc = wid & 3, fr = lane & 15, fq = lane >> 4;
    const int K = g.K, KB = FP8 ? K : 2 * K  , nt = KB / 128;
    int Rr[2], Cc[2]; unsigned voffB[2], voffA[2];
#pragma unroll
    for (int i = 0; i < 2; ++i) { int R, C; stage_rc(tid * 16 + i * 8192, R, C); const int Rb = Epi::PERM ? ((R & ~31) + perm32(R & 31)) : R;
        Rr[i] = R; Cc[i] = C; voffB[i] = (unsigned)(Rb * KB + C * 2); voffA[i] = (unsigned)(R * KB + C * 2); }
    const size_t kstep = (size_t)(BK * 2);
    const size_t hstep = (size_t)HALF * KB;
    const size_t tstep = 2 * hstep;
    const unsigned ldsw = (unsigned)wid * 1024u;
    const int aoff = lds_byte(wr * 64 + fr, fq * 8), boff = lds_byte(wc * 32 + fr, fq * 8);
    const char* Abase = (const char*)g.A;
#define PG8_SA(b, h) (((b) * 2 + (h)) * HTB)
#define PG8_SB(b, h) ((4 + (b) * 2 + (h)) * HTB)
#define PG8_STAGE_B(bufoff, gbase) do { _Pragma("unroll") for (int _i = 0; _i < 2; ++_i) \
        __builtin_amdgcn_global_load_lds((const unsigned*)((const char*)(gbase) + voffB[_i]), (PG8_LAS unsigned*)(lds + (bufoff) + ldsw + _i * 8192), 16, 0, 0); } while (0)
#define PG8_STAGE_A(bufoff, UB, h, kb) do { _Pragma("unroll") for (int _i = 0; _i < 2; ++_i) { \
        const char* _src = AMODE != 0 ? Abase + (size_t)co[h][_i] + (size_t)(kb) : (UB) + (size_t)(h) * hstep + (size_t)(kb) + voffA[_i]; \
        __builtin_amdgcn_global_load_lds((const unsigned*)_src, (PG8_LAS unsigned*)(lds + (bufoff) + ldsw + _i * 8192), 16, 0, 0); } } while (0)
#define PG8_AOFFS(u, OFF) do { int _tb0 = 0, _cn0 = 0; if (AMODE == 1) { _tb0 = __builtin_amdgcn_readfirstlane(g.tb[(u).e]); _cn0 = __builtin_amdgcn_readfirstlane(g.cn[(u).e]); } \
        _Pragma("unroll") for (int _h = 0; _h < 2; ++_h) _Pragma("unroll") for (int _i = 0; _i < 2; ++_i) { \
        int _row = (u).pm * BM + _h * HALF + Rr[_i]; \
        if (AMODE == 1) { const int _loc = _row - _tb0 * BM; const int _rv = g.rowidx[(u).e * M + (_loc < _cn0 ? _loc : 0)]; _row = _loc < _cn0 ? _rv : M; }     \
        (OFF)[_h][_i] = (unsigned)(_row * KB + Cc[_i] * 2); } } while (0)
#define PG8_LD8(p) __builtin_shufflevector(*(const PG8_LAS i32x4*)(p), *(const PG8_LAS i32x4*)((p) + 1024), 0, 1, 2, 3, 4, 5, 6, 7)
#define PG8_LDA(dst, b, h) do { if constexpr (FP8) { _Pragma("unroll") for (int m = 0; m < 4; ++m) dst##8[m] = PG8_LD8(lds + PG8_SA(b, h) + aoff + m * 2048); } else { \
        _Pragma("unroll") for (int m = 0; m < 4; ++m) _Pragma("unroll") for (int k = 0; k < 2; ++k) dst[m][k] = *(const PG8_LAS bf16x8*)(lds + PG8_SA(b, h) + aoff + m * 2048 + k * 1024); } } while (0)
#define PG8_LDB(dst, b, h) do { if constexpr (FP8) { _Pragma("unroll") for (int n = 0; n < 2; ++n) dst##8[n] = PG8_LD8(lds + PG8_SB(b, h) + boff + n * 2048); } else { \
        _Pragma("unroll") for (int n = 0; n < 2; ++n) _Pragma("unroll") for (int k = 0; k < 2; ++k) dst[n][k] = *(const PG8_LAS bf16x8*)(lds + PG8_SB(b, h) + boff + n * 2048 + k * 1024); } } while (0)
#define MMA(ai, bj, At, Bt) do { __builtin_amdgcn_s_setprio(1); if constexpr (FP8) { _Pragma("unroll") for (int m = 0; m < 4; ++m) _Pragma("unroll") for (int n = 0; n < 2; ++n) \
        acc[ai][bj][m][n] = __builtin_amdgcn_mfma_scale_f32_16x16x128_f8f6f4(Bt##8[n], At##8[m], acc[ai][bj][m][n], 0, 0, 0, 0, 0, 0); } else { \
        _Pragma("unroll") for (int m = 0; m < 4; ++m) _Pragma("unroll") for (int n = 0; n < 2; ++n) _Pragma("unroll") for (int k = 0; k < 2; ++k) \
        acc[ai][bj][m][n] = __builtin_amdgcn_mfma_f32_16x16x32_bf16(Bt[n][k], At[m][k], acc[ai][bj][m][n], 0, 0, 0); } __builtin_amdgcn_s_setprio(0); } while (0)
#define PG8_WAIT_V(n) asm volatile("s_waitcnt vmcnt(" #n ")" ::: "memory")
#define PG8_WAIT_L(n) asm volatile("s_waitcnt lgkmcnt(" #n ")" ::: "memory")
#define PG8_BAR __builtin_amdgcn_s_barrier()
#define PG8_SCHED __builtin_amdgcn_sched_barrier(0)
    Unit cur, nxt; int ui = 0;
    if (!S.next(0, cur)) return;
    unsigned co[2][2];
    if constexpr (AMODE != 0) PG8_AOFFS(cur, co);
    const char* cA = Abase + (size_t)cur.pm * tstep;
    f32x4 acc[2][2][4][2];
#pragma unroll
    for (int a = 0; a < 2; ++a)
#pragma unroll
        for (int b = 0; b < 2; ++b)
#pragma unroll
            for (int m = 0; m < 4; ++m)
#pragma unroll
                for (int n = 0; n < 2; ++n) { acc[a][b][m][n] = (f32x4){0.f, 0.f, 0.f, 0.f}; asm volatile("" : "+v"(acc[a][b][m][n])); }
    bf16x8 At[4][2], B0[2][2], B1[2][2]; i32x8 At8[4], B08[2], B18[2];
    const char* cB = (const char*)g.Bt + ((size_t)cur.e * g.estride) * (FP8 ? 1 : 2) + (size_t)cur.pn * tstep;
#define PG8_KO(j, r) ((size_t)(((j) + (r)) & (nt - 1)) * kstep)
    int rc = (cur.pm + cur.pn) & (nt - 1);
    PG8_STAGE_B(PG8_SB(0, 0), cB + PG8_KO(0, rc)); PG8_STAGE_B(PG8_SB(0, 1), cB + hstep + PG8_KO(0, rc)); PG8_STAGE_A(PG8_SA(0, 0), cA, 0, PG8_KO(0, rc)); PG8_STAGE_A(PG8_SA(0, 1), cA, 1, PG8_KO(0, rc));
    if (wr == 1) PG8_BAR;
    PG8_WAIT_V(2); PG8_BAR;
    PG8_STAGE_B(PG8_SB(1, 0), cB + PG8_KO(1, rc)); PG8_STAGE_A(PG8_SA(1, 0), cA, 0, PG8_KO(1, rc)); PG8_STAGE_B(PG8_SB(1, 1), cB + hstep + PG8_KO(1, rc));
    PG8_WAIT_V(6); PG8_BAR;
    for (;;) {
        const bool has_next = S.next(ui + 1, nxt);
        const char* nB = cB; const char* nA = cA; int rn = rc;
        if (has_next) { rn = (nxt.pm + nxt.pn) & (nt - 1); nA = Abase + (size_t)nxt.pm * tstep; nB = (const char*)g.Bt + ((size_t)nxt.e * g.estride) * (FP8 ? 1 : 2) + (size_t)nxt.pn * tstep; }
#pragma unroll 1
        for (int t = 0; t < nt; t += 2) {
            const bool last = (t == nt - 2);
            const size_t kb1 = PG8_KO(t + 1, rc);
            const char* a2 = last ? nA : cA;
            const size_t kb2 = last ? PG8_KO(0, rn) : PG8_KO(t + 2, rc), kb3 = last ? PG8_KO(1, rn) : PG8_KO(t + 3, rc);
            const char* b2 = (last ? nB : cB) + kb2; const char* b3 = (last ? nB : cB) + kb3;
            PG8_LDB(B0, 0, 0); PG8_LDB(B1, 0, 1); PG8_SCHED; PG8_LDA(At, 0, 0); PG8_STAGE_A(PG8_SA(1, 1), cA, 1, kb1);
            if constexpr (AMODE != 0) { if (last && has_next) PG8_AOFFS(nxt, co); }
            PG8_WAIT_V(8); PG8_WAIT_L(0); PG8_BAR; MMA(0, 0, At, B0); MMA(0, 1, At, B1); PG8_BAR; PG8_SCHED;
            PG8_LDA(At, 0, 1); PG8_STAGE_B(PG8_SB(0, 0), b2); PG8_STAGE_B(PG8_SB(0, 1), b2 + hstep); PG8_STAGE_A(PG8_SA(0, 0), a2, 0, kb2);
            PG8_WAIT_V(8); PG8_WAIT_L(0); PG8_BAR; MMA(1, 0, At, B0); MMA(1, 1, At, B1); PG8_BAR; PG8_SCHED;
            PG8_LDB(B0, 1, 0); PG8_LDB(B1, 1, 1); PG8_SCHED; PG8_LDA(At, 1, 0); PG8_STAGE_A(PG8_SA(0, 1), a2, 1, kb2);
            PG8_WAIT_V(8); PG8_WAIT_L(0); PG8_BAR; MMA(0, 0, At, B0); MMA(0, 1, At, B1); PG8_BAR; PG8_SCHED;
            PG8_LDA(At, 1, 1); PG8_STAGE_B(PG8_SB(1, 0), b3); PG8_STAGE_B(PG8_SB(1, 1), b3 + hstep); PG8_STAGE_A(PG8_SA(1, 0), a2, 0, kb3);
            PG8_WAIT_V(8); PG8_WAIT_L(0); PG8_BAR; MMA(1, 0, At, B0); MMA(1, 1, At, B1); PG8_BAR; PG8_SCHED;
        }
        if (wr == 0) PG8_BAR;
        E(acc, cur, wr, wc, fr, fq);
        if (!has_next) break;
#pragma unroll
        for (int a = 0; a < 2; ++a)
#pragma unroll
            for (int b = 0; b < 2; ++b)
#pragma unroll
                for (int m = 0; m < 4; ++m)
#pragma unroll
                    for (int n = 0; n < 2; ++n) { acc[a][b][m][n] = (f32x4){0.f, 0.f, 0.f, 0.f}; asm volatile("" : "+v"(acc[a][b][m][n])); }
        cur = nxt; cB = nB; cA = nA; rc = rn; ++ui;
        if (wr == 1) PG8_BAR;
    }
    PG8_WAIT_V(0);
    PG8_BAR;
#undef PG8_SA
#undef PG8_SB
#undef PG8_STAGE_A
#undef PG8_STAGE_B
#undef PG8_AOFFS
#undef PG8_KO
#undef PG8_LDA
#undef PG8_LDB
#undef MMA
#undef PG8_LD8
#undef PG8_WAIT_V
#undef PG8_WAIT_L
#undef PG8_BAR
#undef PG8_SCHED
}
}

#include <hip/hip_bf16.h>
#include <cmath>
namespace attn_body {
using bf16=__hip_bfloat16;
using bf16x8=__attribute__((ext_vector_type(8)))short;
using s16x4=__attribute__((ext_vector_type(4)))short;
using f32x16=__attribute__((ext_vector_type(16)))float;
using u32x4=__attribute__((ext_vector_type(4)))unsigned;
constexpr int BATCH=4,NHEAD=8,SEQ=8192,D=64,PQ=3072,PO=1024;
constexpr int NW=8,QBLK=32,QB=QBLK*NW,KVBLK=64,NQB=SEQ/QB;
constexpr int ATTN_UNIT_ROWS=QB;
__device__ __forceinline__ int crow(int r,int hi){return (r&3)+8*(r>>2)+4*hi;}
#define SBAR() __builtin_amdgcn_sched_barrier(0)
__device__ __forceinline__ void cmask(f32x16&p0,f32x16&p1,int jb,int qrel,int hi){
  const float NEG=-INFINITY; int kb=64*jb+4*hi;
  #pragma unroll
  for(int r=0;r<16;++r){int kv=kb+(r&3)+8*(r>>2); if(kv>qrel)p0[r]=NEG; if(kv+32>qrel)p1[r]=NEG;}
}

constexpr int NSLOT=3, SLOTB=8192;
constexpr int LDS_K=0, LDS_V=NSLOT*SLOTB, LDS_WS=2*NSLOT*SLOTB, LDS_OST=LDS_WS+NW*64*4, LDS_NF=LDS_OST+NW*4096, LDS_BYTES=LDS_NF+SEQ*4;
constexpr float C2=0.125f*1.4426950408889634f;
__device__ __forceinline__ void glds16(const void*gsrc,unsigned lds_dst){unsigned keep;
  asm volatile("s_mov_b32 %0, m0\n\ts_mov_b32 m0, %2\n\ts_nop 0\n\tglobal_load_lds_dwordx4 %1, off\n\ts_mov_b32 m0, %0":"=&s"(keep):"v"(gsrc),"s"(lds_dst):"memory");}
__device__ __forceinline__ float max3f(float a,float b,float c){float r;asm("v_max3_f32 %0, %1, %2, %3":"=v"(r):"v"(a),"v"(b),"v"(c));return r;}
__device__ __forceinline__ float max2f(float a,float b){float r;asm("v_max_f32_e32 %0, %1, %2":"=v"(r):"v"(a),"v"(b));return r;}
__device__ __forceinline__ float fadd_s(float a,float b){float r;asm("v_add_f32_e32 %0, %1, %2":"=v"(r):"v"(a),"v"(b));return r;}
__device__ __forceinline__ float fsub_s(float a,float b){float r;asm("v_sub_f32_e32 %0, %1, %2":"=v"(r):"v"(a),"v"(b));return r;}
typedef float f32x2_t __attribute__((ext_vector_type(2))); typedef __bf16 bf16x2_t __attribute__((ext_vector_type(2)));
__device__ __forceinline__ unsigned cvtpk_s(float lo,float hi){f32x2_t v={lo,hi};bf16x2_t b=__builtin_convertvector(v,bf16x2_t);return __builtin_bit_cast(unsigned,b);}
#define WAIT_BAR(N) asm volatile("s_waitcnt vmcnt(" #N ") lgkmcnt(0)\n\ts_barrier":::"memory")

__device__ __forceinline__ void qkt(f32x16&p0,f32x16&p1,const char*Kslot,const bf16x8*qr,float a0,float a1,float bq,int r32,int hi){
  const char*kb=Kslot+hi*1024+r32*16;
  #pragma unroll
  for(int d0=0;d0<4;++d0){
    const bf16x8 b0=*reinterpret_cast<const bf16x8*>(kb+d0*2048);
    const bf16x8 b1=*reinterpret_cast<const bf16x8*>(kb+d0*2048+512);
    if(d0==0){const f32x16 z=f32x16{};p0=__builtin_amdgcn_mfma_f32_32x32x2f32(a0,bq,z,0,0,0);p1=__builtin_amdgcn_mfma_f32_32x32x2f32(a1,bq,z,0,0,0);}
    p0=__builtin_amdgcn_mfma_f32_32x32x16_bf16(b0,qr[d0],p0,0,0,0);p1=__builtin_amdgcn_mfma_f32_32x32x16_bf16(b1,qr[d0],p1,0,0,0);}
}
typedef __attribute__((address_space(3))) const char* lds_cptr;
typedef short v4i16_t __attribute__((ext_vector_type(4)));
__device__ __forceinline__ void kload8(bf16x8*kf,lds_cptr kp){
  kf[0]=*(const __attribute__((address_space(3))) bf16x8*)(kp);      kf[1]=*(const __attribute__((address_space(3))) bf16x8*)(kp+512);
  kf[2]=*(const __attribute__((address_space(3))) bf16x8*)(kp+2048); kf[3]=*(const __attribute__((address_space(3))) bf16x8*)(kp+2560);
  kf[4]=*(const __attribute__((address_space(3))) bf16x8*)(kp+4096); kf[5]=*(const __attribute__((address_space(3))) bf16x8*)(kp+4608);
  kf[6]=*(const __attribute__((address_space(3))) bf16x8*)(kp+6144); kf[7]=*(const __attribute__((address_space(3))) bf16x8*)(kp+6656);
}
__device__ __forceinline__ void kload2(bf16x8*kf,lds_cptr kp,int j){ kf[2*j]=*(const __attribute__((address_space(3))) bf16x8*)(kp+j*2048); kf[2*j+1]=*(const __attribute__((address_space(3))) bf16x8*)(kp+j*2048+512); }
__device__ __forceinline__ s16x4 vtr(lds_cptr p){ return __builtin_bit_cast(s16x4,__builtin_amdgcn_ds_read_tr16_b64_v4i16((__attribute__((address_space(3))) v4i16_t*)p)); }
__device__ __forceinline__ float rowmax(const f32x16&p0,const f32x16&p1){
  float a=max3f(p0[0],p0[1],p1[0]),b=max3f(p0[2],p0[3],p1[1]);a=max3f(a,p1[2],p1[3]);
  #pragma unroll
  for(int r=4;r<16;r+=4){a=max3f(a,p0[r],p0[r+1]);b=max3f(b,p0[r+2],p0[r+3]);a=max3f(a,p1[r],p1[r+1]);b=max3f(b,p1[r+2],p1[r+3]);}
  const float m=max2f(a,b);
  auto rr=__builtin_amdgcn_permlane32_swap(__float_as_uint(m),__float_as_uint(m),false,false);
  return max2f(__uint_as_float(rr[0]),__uint_as_float(rr[1]));
}
__device__ __forceinline__ void pv(f32x16*o,int vb,bf16x8 pa0,bf16x8 pa1,bf16x8 pa2,bf16x8 pa3){
  #pragma unroll
  for(int d0=0;d0<2;++d0){s16x4 lo[4],hi[4];
    #pragma unroll
    for(int ks=0;ks<4;++ks){
      asm volatile("ds_read_b64_tr_b16 %0,%1 offset:%c2":"=&v"(lo[ks]):"v"(vb),"i"(d0*4096+ks*1024):"memory");
      asm volatile("ds_read_b64_tr_b16 %0,%1 offset:%c2":"=&v"(hi[ks]):"v"(vb),"i"(d0*4096+ks*1024+512):"memory");}
    asm volatile("s_waitcnt lgkmcnt(0)":::"memory");SBAR();
    #define PK(k) (bf16x8){lo[k][0],lo[k][1],lo[k][2],lo[k][3],hi[k][0],hi[k][1],hi[k][2],hi[k][3]}
    o[d0]=__builtin_amdgcn_mfma_f32_32x32x16_bf16(pa0,PK(0),o[d0],0,0,0);
    o[d0]=__builtin_amdgcn_mfma_f32_32x32x16_bf16(pa1,PK(1),o[d0],0,0,0);
    o[d0]=__builtin_amdgcn_mfma_f32_32x32x16_bf16(pa2,PK(2),o[d0],0,0,0);
    o[d0]=__builtin_amdgcn_mfma_f32_32x32x16_bf16(pa3,PK(3),o[d0],0,0,0);
    #undef PK
  }
}

#ifndef ATTN_STORE16
#define ATTN_STORE16(p,v) (*(u32x4*)(p)=(v))
#endif
template<int THRL> __device__ __forceinline__ void attn_unit(int b,int h,int qb,const bf16*Q,const bf16*__restrict__ K,const bf16*__restrict__ V,bf16*O,const float*LFg,const float*segt,float thrb,char*shm,const float*cw1,unsigned char*cW1F,int cpiece){
  const int tid=threadIdx.x,lane=tid&63,r32=lane&31,hi=lane>>5; const int wid=__builtin_amdgcn_readfirstlane(tid>>6);
  typedef float cf32x4 __attribute__((ext_vector_type(4))); cf32x4 cpv[8]; unsigned char* cpd;
  { const int s_=24*1024+cpiece*8+wid, e_=s_>>10, r_=s_&1023, q_=r_>>1, sub_=r_&1, k0_=64*(2*(q_>>6)+sub_), n_=32*(q_&63)+(lane&7)*4, kr_=lane>>3;
    const int drow_=((n_&1023)>>7)*256+(n_>>10)*128+(n_&127);
    const float* src_=cw1+(size_t)e_*1024*2048+(size_t)(k0_+8*kr_)*2048+n_; cpd=cW1F+(size_t)e_*2048*1024+(size_t)drow_*1024+k0_+8*kr_;
    #pragma unroll
    for(int i=0;i<8;++i)cpv[i]=__builtin_nontemporal_load((const cf32x4*)(src_+(size_t)i*2048));
    asm volatile("":::"memory"); }
  const long rowbase=(long)b*SEQ; const int q0=qb*QB;
  const int NTfull=(q0+QB)/KVBLK; int ts;
  float pf_[8]; { float a_=0.f;
  #pragma unroll
  for(int s_=0;s_<8;++s_){ pf_[s_]=a_; a_+=segt[s_]; } }
  #define NFBASE(sgi) ({ float b_=0.f; _Pragma("unroll") for(int s_=1;s_<8;++s_) b_=((sgi)>=s_)?pf_[s_]:b_; b_; })
  #define NFV(i) (-(LFg[(i)]+NFBASE((i)>>10))*LOG2E)
  { const float nfq0=NFV(q0); const int t0=lane,t1=lane+64; const int i0_=64*(t0<NTfull?t0:0)+63,i1_=64*(t1<NTfull?t1:0)+63;
    const bool s0=(t0<NTfull)&&(nfq0-NFV(i0_)>thrb), s1=(t1<NTfull)&&(nfq0-NFV(i1_)>thrb);
    ts=__popcll(__ballot(s0))+__popcll(__ballot(s1)); ts&=~1; ts=ts<NTfull-4?ts:NTfull-4; ts=__builtin_amdgcn_readfirstlane(ts); }
  { typedef unsigned cu32x2 __attribute__((ext_vector_type(2)));
    #pragma unroll
    for(int c=0;c<4;++c){ cu32x2 o_; o_.x=pk4_fp8(cpv[0][c]*32.f,cpv[1][c]*32.f,cpv[2][c]*32.f,cpv[3][c]*32.f); o_.y=pk4_fp8(cpv[4][c]*32.f,cpv[5][c]*32.f,cpv[6][c]*32.f,cpv[7][c]*32.f);
      *(cu32x2*)(cpd+(size_t)c*1024)=o_; } }
  const bf16*Qw=Q+(rowbase+q0+wid*QBLK)*PQ+h*D;
  const bf16*Kh=K+rowbase*PQ+h*D,*Vh=V+rowbase*PQ+h*D;
  { typedef float f4_t __attribute__((ext_vector_type(4))); __attribute__((address_space(3))) f4_t* nfw=(__attribute__((address_space(3))) f4_t*)((__attribute__((address_space(3))) char*)shm+LDS_NF);
    const f4_t* lfg=(const f4_t*)LFg; for(int i=ts*16+tid;i<64*(qb+1);i+=NW*64){ const f4_t l_=lfg[i]; const float bb_=NFBASE(i>>8); nfw[i]=-(l_+bb_)*LOG2E; } }
  #undef NFV
  #undef NFBASE
  const __attribute__((address_space(3))) float* nfl=(const __attribute__((address_space(3))) float*)((__attribute__((address_space(3))) char*)shm+LDS_NF);
  const unsigned lds0=(unsigned)(uintptr_t)shm;
  float*wsf=(float*)(shm+LDS_WS)+wid*64;
  const bf16*ksrc=Kh+(long)(ts*KVBLK+lane)*PQ+wid*8;
  const bf16*vsrc=Vh+(long)(ts*KVBLK+16*(wid&3)+(lane>>2))*PQ+(wid>>2)*32+(lane&3)*8;
  const unsigned kdst=lds0+LDS_K+wid*1024, vdst=lds0+LDS_V+wid*1024;
  #define DMA_K(t,slot) glds16(ksrc+(long)(t)*KVBLK*PQ,(unsigned)__builtin_amdgcn_readfirstlane(kdst+(slot)))
  #define DMA_V(t,slot) glds16(vsrc+(long)(t)*KVBLK*PQ,(unsigned)__builtin_amdgcn_readfirstlane(vdst+(slot)))
  const int vb0=(int)(lds0+LDS_V)+((lane>>4)&1)*32+(lane&3)*8+(4*hi+((lane&15)>>2))*64;
  const char*Kbase=shm+LDS_K; bf16x8 kf[8];
  const lds_cptr shm3=(lds_cptr)shm; const lds_cptr kp0=shm3+LDS_K+hi*1024+r32*16; const lds_cptr vp0=shm3+LDS_V+((lane>>4)&1)*32+(lane&3)*8+(4*hi+((lane&15)>>2))*64;
  const int NT=NTfull-ts;
  DMA_K(0,0);DMA_V(0,0);DMA_K(1,SLOTB);
  bf16x8 qr[4];
  #pragma unroll
  for(int d0=0;d0<4;++d0)qr[d0]=*reinterpret_cast<const bf16x8*>(&Qw[(long)r32*PQ+d0*16+hi*8]);
  float mhat=0.f,l_reg=0.f,bq=0.f;f32x16 o[2];o[0]=f32x16{};o[1]=f32x16{};
  #define BQ() (hi?-mhat:1.f)
  const __attribute__((address_space(3))) float* nfl_t=nfl+ts*64;
  #define NFA(t,half) (hi?1.f:nfl_t[(t)*64+(half)*32+r32])
  const int qrel=wid*QBLK+r32;
  #define CMASK(P0,P1,t) do{int jb_=(t)-(NT-4); if(jb_>=0)cmask(P0,P1,jb_,qrel,hi);}while(0)
  bool resc=false;
  #define START(P0,P1) do{ const float rm=rowmax(P0,P1); resc=false; \
    { const float dl=__builtin_fmaxf(rm,0.f); mhat=fadd_s(mhat,dl); \
      _Pragma("unroll") for(int r=0;r<16;++r){P0[r]=fsub_s(P0[r],dl);P1[r]=fsub_s(P1[r],dl);} \
      bq=BQ(); } \
    _Pragma("unroll") for(int r=0;r<16;++r)P0[r]=__builtin_amdgcn_exp2f(P0[r]); }while(0)
  #define RESC() do{ if(resc){ asm volatile("s_waitcnt lgkmcnt(0)":::"memory"); \
      _Pragma("unroll") for(int d_=0;d_<2;++d_) _Pragma("unroll") for(int r=0;r<16;++r)o[d_][r]*=wsf[crow(r,hi)]; } }while(0)
  f32x16 pA0,pA1,pB0,pB1;
  int sl_prev=0,sl_cur=0,sl_next=SLOTB;
  #define ROT() do{sl_prev=sl_cur;sl_cur=sl_next;sl_next=(sl_next==(NSLOT-1)*SLOTB)?0:sl_next+SLOTB;}while(0)
  DMA_K(2,2*SLOTB);
  WAIT_BAR(3);
  mhat=nfl[q0+wid*QBLK+r32]; bq=BQ();
  qkt(pA0,pA1,Kbase,qr,NFA(0,0),NFA(0,1),bq,r32,hi);asm volatile("s_nop 15\n\ts_nop 7":"+v"(pA0),"+v"(pA1));CMASK(pA0,pA1,0);
  START(pA0,pA1);
  _Pragma("unroll") for(int r=0;r<16;++r)pA1[r]=__builtin_amdgcn_exp2f(pA1[r]);
  WAIT_BAR(0);
  DMA_K(3,0);DMA_V(1,SLOTB);
  ROT();
  kload8(kf,kp0+sl_cur);
  WAIT_BAR(2);
  s16x4 vlo[8],vhi[8]; u32x4 pw0,pw1,pw2,pw3;
  #define PKW(P,B) cvtpk_s(P[B],P[B+1])
  #define PAF(k) __builtin_bit_cast(bf16x8,pw##k)
  #define VFR(i) (bf16x8){vlo[i][0],vlo[i][1],vlo[i][2],vlo[i][3],vhi[i][0],vhi[i][1],vhi[i][2],vhi[i][3]}
  #define PIN(x) asm volatile("":"+v"(x))
  #define MX3(a,b,c) __builtin_fmaxf(__builtin_fmaxf((a),(b)),(c))
  #define GAPA(MF,A0,A1,A2,A3,W0,W1,PW) do{ MF; sacc+=A0; sacc+=A1; sacc+=A2; sacc+=A3; PIN(sacc); W0; W1; PIN(PW); SBAR(); }while(0)
  #define EX(v) __builtin_amdgcn_exp2f(v)
  #define GAPB(MF,X,B) do{ MF; X[B]=EX(X[B]); X[B+1]=EX(X[B+1]); X[B+2]=EX(X[B+2]); X[B+3]=EX(X[B+3]); PIN(X); SBAR(); }while(0)
  #define VRD(i) do{ vlo[i]=vtr(vp_+(((i)>>2)*4096+((i)&3)*1024)); vhi[i]=vtr(vp_+(((i)>>2)*4096+((i)&3)*1024+512)); }while(0)
  #define KRD(G,j) do{ if(G){ kload2(kf,kp0+sl_next,j); SBAR(); } }while(0)
  #define STEP(C0,C1,P0,P1,t,GK,GV,GL) do{ SBAR(); \
    const lds_cptr vp_=vp0+sl_prev; \
    { const float a0_=NFA(t,0),a1_=NFA(t,1); const f32x16 z_=f32x16{}; C0=__builtin_amdgcn_mfma_f32_32x32x2f32(a0_,bq,z_,0,0,0); C1=__builtin_amdgcn_mfma_f32_32x32x2f32(a1_,bq,z_,0,0,0); } SBAR(); \
    VRD(0); SBAR(); float sacc=(P0[0]+P0[1]); \
    GAPA(C0=__builtin_amdgcn_mfma_f32_32x32x16_bf16(kf[0],qr[0],C0,0,0,0), P0[2],P0[3],P0[4],P0[5],     pw0[0]=PKW(P0,0), pw0[1]=PKW(P0,2), pw0); \
    VRD(4); SBAR(); GAPA(C1=__builtin_amdgcn_mfma_f32_32x32x16_bf16(kf[1],qr[0],C1,0,0,0), P0[6],P0[7],P0[8],P0[9],     pw0[2]=PKW(P0,4), pw0[3]=PKW(P0,6), pw0); \
    VRD(1); SBAR(); GAPA(C0=__builtin_amdgcn_mfma_f32_32x32x16_bf16(kf[2],qr[1],C0,0,0,0),   P0[10],P0[11],P0[12],P0[13], pw1[0]=PKW(P0,8), pw1[1]=PKW(P0,10), pw1); \
    VRD(5); SBAR(); GAPA(C1=__builtin_amdgcn_mfma_f32_32x32x16_bf16(kf[3],qr[1],C1,0,0,0),   P0[14],P0[15],P1[0],P1[1],   pw1[2]=PKW(P0,12),pw1[3]=PKW(P0,14), pw1); \
    VRD(2); SBAR(); GAPA(C0=__builtin_amdgcn_mfma_f32_32x32x16_bf16(kf[4],qr[2],C0,0,0,0),   P1[2],P1[3],P1[4],P1[5],     pw2[0]=PKW(P1,0), pw2[1]=PKW(P1,2), pw2); \
    VRD(6); SBAR(); GAPA(C1=__builtin_amdgcn_mfma_f32_32x32x16_bf16(kf[5],qr[2],C1,0,0,0),   P1[6],P1[7],P1[8],P1[9],     pw2[2]=PKW(P1,4), pw2[3]=PKW(P1,6), pw2); \
    VRD(3); SBAR(); GAPA(C0=__builtin_amdgcn_mfma_f32_32x32x16_bf16(kf[6],qr[3],C0,0,0,0),   P1[10],P1[11],P1[12],P1[13], pw3[0]=PKW(P1,8), pw3[1]=PKW(P1,10), pw3); \
    VRD(7); SBAR(); GAPA(C1=__builtin_amdgcn_mfma_f32_32x32x16_bf16(kf[7],qr[3],C1,0,0,0),   P1[14],P1[15],0.f,0.f,       pw3[2]=PKW(P1,12),pw3[3]=PKW(P1,14), pw3); \
    l_reg+=sacc; \
    if(GK){DMA_K((t)+3,sl_cur);} if(GV){DMA_V((t)+1,sl_next);} \
    CMASK(C0,C1,t); \
    { float a=MX3(C0[0],C0[1],C1[0]),b=MX3(C0[2],C0[3],C1[1]); a=MX3(a,C1[2],C1[3]); \
      _Pragma("unroll") for(int r=4;r<16;r+=4){a=MX3(a,C0[r],C0[r+1]);b=MX3(b,C0[r+2],C0[r+3]);a=MX3(a,C1[r],C1[r+1]);b=MX3(b,C1[r+2],C1[r+3]);} \
      float rm=__builtin_fmaxf(a,b); { auto rr=__builtin_amdgcn_permlane32_swap(__float_as_uint(rm),__float_as_uint(rm),false,false); rm=__builtin_fmaxf(__uint_as_float(rr[0]),__uint_as_float(rr[1])); } \
      resc=false; \
      if(__builtin_expect(__any(rm>(float)THRL),0)){ const float dl=__builtin_fmaxf(rm,0.f); mhat+=dl; \
        _Pragma("unroll") for(int r=0;r<16;++r){C0[r]-=dl;C1[r]-=dl;} \
        bq=BQ(); \
        const float f=__builtin_amdgcn_exp2f(-dl); l_reg*=f; if(hi==0)wsf[r32]=f; resc=true; } } \
    SBAR(); \
    GAPB(o[0]=__builtin_amdgcn_mfma_f32_32x32x16_bf16(PAF(0),VFR(0),o[0],0,0,0), C0,0); \
    GAPB(o[1]=__builtin_amdgcn_mfma_f32_32x32x16_bf16(PAF(0),VFR(4),o[1],0,0,0), C0,4); \
    KRD(GL,0); GAPB(o[0]=__builtin_amdgcn_mfma_f32_32x32x16_bf16(PAF(1),VFR(1),o[0],0,0,0), C0,8); \
    KRD(GL,1); GAPB(o[1]=__builtin_amdgcn_mfma_f32_32x32x16_bf16(PAF(1),VFR(5),o[1],0,0,0), C0,12); \
    KRD(GL,2); GAPB(o[0]=__builtin_amdgcn_mfma_f32_32x32x16_bf16(PAF(2),VFR(2),o[0],0,0,0), C1,0); \
    KRD(GL,3); GAPB(o[1]=__builtin_amdgcn_mfma_f32_32x32x16_bf16(PAF(2),VFR(6),o[1],0,0,0), C1,4); \
    GAPB(o[0]=__builtin_amdgcn_mfma_f32_32x32x16_bf16(PAF(3),VFR(3),o[0],0,0,0), C1,8); \
    GAPB(o[1]=__builtin_amdgcn_mfma_f32_32x32x16_bf16(PAF(3),VFR(7),o[1],0,0,0), C1,12); \
    }while(0)
  int t=1;
  #undef CMASK
  #define CMASK(P0,P1,t) do{}while(0)
  for(;t+5<NT;t+=2){
    STEP(pB0,pB1,pA0,pA1,t,true,true,true);     WAIT_BAR(2); RESC(); ROT();
    STEP(pA0,pA1,pB0,pB1,t+1,true,true,true);   WAIT_BAR(2); RESC(); ROT();
  }
  #undef CMASK
  #define CMASK(P0,P1,t) do{int jb_=(t)-(NT-4); if(jb_>=0)cmask(P0,P1,jb_,qrel,hi);}while(0)
  #define ENDW(tt) do{ if((tt)+3<NT){WAIT_BAR(2);} else if((tt)+2<NT){WAIT_BAR(1);} else {WAIT_BAR(0);} }while(0)
  for(;t+1<NT;t+=2){
    STEP(pB0,pB1,pA0,pA1,t,(t+3<NT),(t+1<NT),(t+1<NT));       ENDW(t);   RESC(); ROT();
    STEP(pA0,pA1,pB0,pB1,t+1,(t+4<NT),(t+2<NT),(t+2<NT));     ENDW(t+1); RESC(); ROT();
  }
  STEP(pB0,pB1,pA0,pA1,NT-1,false,false,false); RESC();
  { float sacc=pB0[0]+pB0[1]; _Pragma("unroll") for(int r=2;r<16;++r)sacc+=pB0[r]; _Pragma("unroll") for(int r=0;r<16;++r)sacc+=pB1[r]; l_reg+=sacc;
    pw0=(u32x4){PKW(pB0,0),PKW(pB0,2),PKW(pB0,4),PKW(pB0,6)};pw1=(u32x4){PKW(pB0,8),PKW(pB0,10),PKW(pB0,12),PKW(pB0,14)};pw2=(u32x4){PKW(pB1,0),PKW(pB1,2),PKW(pB1,4),PKW(pB1,6)};pw3=(u32x4){PKW(pB1,8),PKW(pB1,10),PKW(pB1,12),PKW(pB1,14)};
    SBAR(); pv(o,vb0+sl_cur,PAF(0),PAF(1),PAF(2),PAF(3)); }
  #undef PKW
  #undef PAF
  #undef VFR
  #undef PIN
  #undef MX3
  #undef GAPA
  #undef GAPB
  #undef EX
  #undef VRD
  #undef KRD
  #undef STEP
  #undef ENDW
  {auto rr=__builtin_amdgcn_permlane32_swap(__float_as_uint(l_reg),__float_as_uint(l_reg),false,false);l_reg=__uint_as_float(rr[0])+__uint_as_float(rr[1]);}
  if(hi==0)wsf[32+r32]=l_reg;asm volatile("s_waitcnt lgkmcnt(0)":::"memory");
  float rli[16];
  #pragma unroll
  for(int r=0;r<16;++r)rli[r]=__builtin_amdgcn_rcpf(wsf[32+crow(r,hi)]);
  bf16*Ow=O+(rowbase+q0+wid*QBLK)*PO+h*D;
  { bf16*stg=(bf16*)(shm+LDS_OST)+wid*2048;
    #pragma unroll
    for(int r=0;r<16;++r){const int orow=crow(r,hi);
      #pragma unroll
      for(int d0=0;d0<2;++d0)stg[orow*64+d0*32+r32]=__float2bfloat16(o[d0][r]*rli[r]);}
    asm volatile("s_waitcnt lgkmcnt(0)":::"memory");
    #pragma unroll
    for(int i=0;i<4;++i){const int row=i*8+(lane>>3),ch=lane&7; const u32x4 v=*(const u32x4*)(stg+row*64+ch*8); ATTN_STORE16(Ow+(long)row*PO+ch*8,v);} }
  asm volatile("s_waitcnt lgkmcnt(0)\n\ts_barrier":::"memory");
  #undef DMA_K
  #undef DMA_V
  #undef CMASK
  #undef START
  #undef RESC
  #undef ROT
  #undef BQ
  #undef NFA
}
constexpr int ATTN_LDS_BYTES=LDS_BYTES;
struct AttnTensors { const bf16* Q; const bf16* K; const bf16* V; bf16* O; const float* LF; const float* SEGT;   const float* udmin;   const unsigned* qk2max;   const float* cw1; unsigned char* cW1F;   };
struct AttnUnit { int bh; int qb; };
struct StaticOrder {
  int vcu;
  __device__ __forceinline__ explicit StaticOrder(int grid,int block):vcu((block%8)*(grid/8)+block/8){}
  __device__ __forceinline__ bool next(int i,AttnUnit&u)const{ if(i>=4)return false; const int s=vcu&7; u.bh=vcu>>3; u.qb=(i==0)?s:(i==1)?15-s:(i==2)?16+s:31-s; return true; }
  __device__ __forceinline__ void a_ready(const AttnUnit&)const{}
  __device__ __forceinline__ void done(const AttnUnit&)const{}
};
constexpr int ATT_TAB=LDS_BYTES;
template<int THRL=8> __device__ __forceinline__ void attn_phase_queue(char*lds,const AttnTensors&T,unsigned*queue){
  typedef __attribute__((address_space(3))) float lfloat; typedef __attribute__((address_space(3))) int lint;
  lfloat*thr_l=(lfloat*)((__attribute__((address_space(3))) char*)lds+ATT_TAB); lint*cnt_l=(lint*)(thr_l+32); lint*ord_l=cnt_l+32; lint*idx_l=ord_l+32; lfloat*udm_l=thr_l+128; lfloat*uq_l=udm_l+1024; lfloat*k2_l=uq_l+1024;
  const int tid=threadIdx.x;
  if(tid<32){ const float q2=__uint_as_float(__hip_atomic_load(T.qk2max+tid,__ATOMIC_RELAXED,__HIP_MEMORY_SCOPE_AGENT)),k2=__uint_as_float(__hip_atomic_load(T.qk2max+32+tid,__ATOMIC_RELAXED,__HIP_MEMORY_SCOPE_AGENT));
    thr_l[tid]=sqrtf(q2*k2)+40.f; cnt_l[tid]=0; k2_l[tid]=k2; }
  { int i0=tid; asm volatile("":"+v"(i0)); for(int i=i0;i<1024;i+=NW*64){ udm_l[i]=T.udmin[i]; uq_l[i]=T.udmin[1024+i]; } }
  __syncthreads();
  { const int bh=tid>>4,part=tid&15; const float*lf=T.LF+(size_t)bh*SEQ; const float*sgt=T.SEGT+bh*8; float sgp[8]; float acc_=0.f;
    #pragma unroll
    for(int s_=0;s_<8;++s_){ sgp[s_]=acc_; acc_+=sgt[s_]; }
    const float nfq0=-(lf[31*QB]+sgp[(31*QB)>>10])*LOG2E,th=thr_l[bh]-udm_l[bh*32+31]; int c=0;
    #pragma unroll
    for(int i=0;i<8;++i){ const int ii=64*(part*8+i)+63; c+=(nfq0-(-(lf[ii]+sgp[ii>>10])*LOG2E)>th)?1:0; }
    __hip_atomic_fetch_add(cnt_l+bh,c,__ATOMIC_RELAXED,__HIP_MEMORY_SCOPE_WORKGROUP); }
  __syncthreads();
  if(tid<32){ const int mine=cnt_l[tid]; int rank=0;
    for(int j=0;j<32;++j){ const int o=cnt_l[j]; rank+=(o<mine||(o==mine&&j<tid))?1:0; }
    ord_l[rank]=tid; }
  __syncthreads();
  for(;;){
    if(tid==0)idx_l[0]=(int)__hip_atomic_fetch_add(queue,1u,__ATOMIC_RELAXED,__HIP_MEMORY_SCOPE_AGENT);
    __syncthreads();
    const int idx=__builtin_amdgcn_readfirstlane(idx_l[0]);
    if(idx>=BATCH*NHEAD*NQB)break;
    const int bh=__builtin_amdgcn_readfirstlane(ord_l[idx>>5]),qb=31-(idx&31);
    const float thrb=__builtin_bit_cast(float,__builtin_amdgcn_readfirstlane(__builtin_bit_cast(int,sqrtf(uq_l[bh*32+qb]*k2_l[bh])+40.f-udm_l[bh*32+qb])));
    attn_unit<THRL>(bh/NHEAD,bh%NHEAD,qb,T.Q,T.K,T.V,T.O,T.LF+(size_t)bh*SEQ,T.SEGT+bh*8,thrb,lds,T.cw1,T.cW1F,idx);
  }
}
#undef SBAR
#undef WAIT_BAR
}


namespace gla {
typedef short bf16x8 __attribute__((ext_vector_type(8)));
typedef short s16x4 __attribute__((ext_vector_type(4)));
typedef float f32x4 __attribute__((ext_vector_type(4)));
typedef unsigned u32x4 __attribute__((ext_vector_type(4)));
#define GL_LAS __attribute__((address_space(3)))
constexpr int AST = 272, KST = 144, BST = 272;
constexpr int L_A = 0, L_K = 17408, L_B = 26624, L_Z = 61440, L_TOT = 65536, L_SS = 67584, L_END = 69632;
constexpr int NCH = 2048;
__device__ __forceinline__ s16x4 tr4(GL_LAS const unsigned char* p) { return __builtin_bit_cast(s16x4, __builtin_amdgcn_ds_read_tr16_b64_v4i16((GL_LAS s16x4*)p)); }
__device__ __forceinline__ float logsig_fast(float x) { return fminf(x, 0.f) - __logf(1.f + __expf(-fabsf(x))); }

struct UnitIn { u32x4 v[2], sp[2]; f32x4 z; unsigned short q[8], k[8], g[16]; uint2 gp[4]; unsigned qk[8]; uint2 kv[4]; float dk; };
template <bool PC>
__device__ __forceinline__ void unit_load(UnitIn& R, int ch, const bf16_t* P, const float* ZF, const bf16_t* SP, int tid, int wave, int lane) {
    const int bh = ch >> 7, n = ch & 127, b = bh >> 2, h = bh & 3; const size_t row0 = (size_t)b * S + n * 64;
#pragma unroll
    for (int u = 0; u < 2; ++u) { const int c = tid + 512 * u, row = c >> 4, chn = c & 15;
        R.v[u] = *(const u32x4*)(P + (row0 + row) * NPROJ + PC_VG + h * 128 + chn * 8);
        if (PC) R.sp[u] = *(const u32x4*)(SP + (size_t)ch * 8192 + row * 128 + chn * 8); }
    { const int t = (tid & 255) >> 2, r4 = (tid & 3) * 4; R.z = *(const f32x4*)(ZF + (row0 + t) * 32 + r4); }
#pragma unroll
    for (int i = 0; i < 8; ++i) { R.k[i] = P[(row0 + 8 * wave + i) * NPROJ + PC_KG + h * 64 + lane]; R.q[i] = P[(row0 + 8 * wave + i) * NPROJ + PC_QG + h * 64 + lane]; }
    if (PC) { const int fr = lane & 15, fq = lane >> 4;
#pragma unroll
        for (int it = 0; it < 4; ++it)
#pragma unroll
            for (int r = 0; r < 4; ++r) R.g[it * 4 + r] = P[(row0 + 16 * it + 4 * fq + r) * NPROJ + PC_GG + h * 128 + 16 * wave + fr]; }
    asm volatile("" ::: "memory");
}
template <bool PC>
__device__ __forceinline__ void chunk_decay(GL_LAS unsigned char* lds, const UnitIn& R, const float (&wk)[16], float bk, int tid, int wave, int lane, float (&bcs)[8], float& blast) {
    GL_LAS float* zs = (GL_LAS float*)(lds + L_Z); GL_LAS float* tot = (GL_LAS float*)(lds + L_TOT);
#pragma unroll
    for (int u = 0; u < 2; ++u) { const int c = tid + 512 * u, row = c >> 4, chn = c & 15;
        *(GL_LAS u32x4*)(lds + L_B + row * BST + chn * 16) = R.v[u];
        if (PC) *(GL_LAS u32x4*)(lds + L_B + (64 + row) * BST + chn * 16) = R.sp[u]; }
    if (tid < 256) { const int t = tid >> 2, r4 = (tid & 3) * 4; *(GL_LAS f32x4*)(zs + t * 16 + r4) = R.z; }
    __syncthreads();
    float run = 0.f;
#pragma unroll
    for (int i = 0; i < 8; ++i) { const int t = 8 * wave + i; float gk = bk;
#pragma unroll
        for (int r4 = 0; r4 < 4; ++r4) { const f32x4 z = *(GL_LAS const f32x4*)(zs + t * 16 + r4 * 4); gk += z[0] * wk[r4 * 4] + z[1] * wk[r4 * 4 + 1] + z[2] * wk[r4 * 4 + 2] + z[3] * wk[r4 * 4 + 3]; }
        run += logsig_fast(gk) * (1.f / 16.f); bcs[i] = run; }
    tot[wave * 64 + lane] = run;
    __syncthreads();
    float base = 0.f, all = 0.f;
#pragma unroll
    for (int w = 0; w < 8; ++w) { const float t = tot[w * 64 + lane]; all += t; if (w < wave) base += t; }
#pragma unroll
    for (int i = 0; i < 8; ++i) bcs[i] += base;
    blast = all;
}

__device__ __forceinline__ void phase_a_unit(GL_LAS unsigned char* lds, int ch, const UnitIn& R, const float (&wk)[16], float bk, float* KV, float* DEC, float* BCS, f32x4 (&Sseg)[4], float& Dseg) {
    const int tid = threadIdx.x, lane = tid & 63, wave = __builtin_amdgcn_readfirstlane(tid >> 6);
    float bcs[8], blast;
    chunk_decay<false>(lds, R, wk, bk, tid, wave, lane, bcs, blast);
#pragma unroll
    for (int i = 0; i < 8; ++i) ((unsigned*)BCS)[((size_t)ch * 64 + 8 * wave + i) * 64 + lane] = pk2(bf2f(R.q[i]) * __expf(bcs[i]) * 0.125f, bf2f(R.k[i]) * __expf(-bcs[i]));
    { u32x4 w;
      w.x = pk2(bf2f(R.k[0]) * __expf(blast - bcs[0]), bf2f(R.k[1]) * __expf(blast - bcs[1])); w.y = pk2(bf2f(R.k[2]) * __expf(blast - bcs[2]), bf2f(R.k[3]) * __expf(blast - bcs[3]));
      w.z = pk2(bf2f(R.k[4]) * __expf(blast - bcs[4]), bf2f(R.k[5]) * __expf(blast - bcs[5])); w.w = pk2(bf2f(R.k[6]) * __expf(blast - bcs[6]), bf2f(R.k[7]) * __expf(blast - bcs[7]));
      *(GL_LAS u32x4*)(lds + L_K + lane * KST + wave * 16) = w;
      if (wave == 0) DEC[(size_t)ch * 64 + lane] = __expf(blast); }
    __syncthreads();
    { const int mt = wave & 3, ng = wave >> 2, fr = lane & 15, fq = lane >> 4, q = fr >> 2, p = fr & 3;
      f32x4 acc[4];
#pragma unroll
      for (int t = 0; t < 4; ++t) acc[t] = (f32x4){0.f, 0.f, 0.f, 0.f};
#pragma unroll
      for (int ks = 0; ks < 2; ++ks) {
          const bf16x8 a = *(GL_LAS const bf16x8*)(lds + L_K + (16 * mt + fr) * KST + (32 * ks + 8 * fq) * 2);
#pragma unroll
          for (int t = 0; t < 4; ++t) { const int nt = ng * 4 + t; GL_LAS const unsigned char* bp = lds + L_B + (32 * ks + 8 * fq + q) * BST + (16 * nt + 4 * p) * 2;
              const s16x4 lo = tr4(bp), hi = tr4(bp + 4 * BST);
              const bf16x8 bb = (bf16x8){lo[0], lo[1], lo[2], lo[3], hi[0], hi[1], hi[2], hi[3]};
              acc[t] = __builtin_amdgcn_mfma_f32_16x16x32_bf16(bb, a, acc[t], 0, 0, 0); } }
      const float dk = __shfl(__expf(blast), 16 * mt + fr);
#pragma unroll
      for (int t = 0; t < 4; ++t) Sseg[t] = Sseg[t] * dk + acc[t];
      Dseg *= dk; }
    __syncthreads();
}

__device__ __forceinline__ void phase_c_unit(GL_LAS unsigned char* lds, int ch, const UnitIn& R, const float (&wk)[16], float bk, const float* gain, bf16_t* AO) {
    const int tid = threadIdx.x, lane = tid & 63, wave = __builtin_amdgcn_readfirstlane(tid >> 6);
    const int bh = ch >> 7, n = ch & 127, b = bh >> 2, h = bh & 3; const size_t row0 = (size_t)b * S + n * 64;
    float bcs[8], blast;
    chunk_decay<true>(lds, R, wk, bk, tid, wave, lane, bcs, blast);
#pragma unroll
    for (int i = 0; i < 8; ++i) { const int t = 8 * wave + i;
        *(GL_LAS bf16_t*)(lds + L_A + t * AST + (64 + lane) * 2) = (bf16_t)f2bf(bf2f(R.q[i]) * __expf(bcs[i]) * 0.125f);
        *(GL_LAS bf16_t*)(lds + L_K + t * KST + lane * 2) = (bf16_t)f2bf(bf2f(R.k[i]) * __expf(-bcs[i])); }
    __syncthreads();
    const int fr = lane & 15, fq = lane >> 4, q = fr >> 2, p = fr & 3;
    { const int it = wave >> 1;
#pragma unroll
      for (int u = 0; u < 2; ++u) { const int jt = 2 * (wave & 1) + u;
          f32x4 acc = (f32x4){0.f, 0.f, 0.f, 0.f};
          if (jt <= it) {
#pragma unroll
              for (int ks = 0; ks < 2; ++ks) {
                  const bf16x8 a = *(GL_LAS const bf16x8*)(lds + L_A + (16 * it + fr) * AST + (64 + 32 * ks + 8 * fq) * 2);
                  const bf16x8 bb = *(GL_LAS const bf16x8*)(lds + L_K + (16 * jt + fr) * KST + (32 * ks + 8 * fq) * 2);
                  acc = __builtin_amdgcn_mfma_f32_16x16x32_bf16(a, bb, acc, 0, 0, 0); } }
#pragma unroll
          for (int r = 0; r < 4; ++r) { const int i = 16 * it + 4 * fq + r, j = 16 * jt + fr;
              *(GL_LAS bf16_t*)(lds + L_A + i * AST + j * 2) = (bf16_t)f2bf(j <= i ? acc[r] : 0.f); } } }
    __syncthreads();
    f32x4 o[4];
#pragma unroll
    for (int it = 0; it < 4; ++it) o[it] = (f32x4){0.f, 0.f, 0.f, 0.f};
#pragma unroll
    for (int ks = 0; ks < 4; ++ks) { GL_LAS const unsigned char* bp = lds + L_B + (32 * ks + 8 * fq + q) * BST + (16 * wave + 4 * p) * 2;
        const s16x4 lo = tr4(bp), hi = tr4(bp + 4 * BST);
        const bf16x8 bb = (bf16x8){lo[0], lo[1], lo[2], lo[3], hi[0], hi[1], hi[2], hi[3]};
#pragma unroll
        for (int it = 0; it < 4; ++it) { const bf16x8 a = *(GL_LAS const bf16x8*)(lds + L_A + (16 * it + fr) * AST + (32 * ks + 8 * fq) * 2);
            o[it] = __builtin_amdgcn_mfma_f32_16x16x32_bf16(a, bb, o[it], 0, 0, 0); } }
    GL_LAS float* ssb = (GL_LAS float*)(lds + L_SS);
#pragma unroll
    for (int it = 0; it < 4; ++it)
#pragma unroll
        for (int r = 0; r < 4; ++r) { float s = o[it][r] * o[it][r];
            s = row16_sum(s);
            if (fr == 0) ssb[(16 * it + 4 * fq + r) * 8 + wave] = s; }
    __syncthreads();
    { const int v = 16 * wave + fr; const float gn = gain[h * 128 + v];
#pragma unroll
      for (int it = 0; it < 4; ++it)
#pragma unroll
          for (int r = 0; r < 4; ++r) { const int i = 16 * it + 4 * fq + r;
              const f32x4 s0 = *(GL_LAS const f32x4*)(ssb + i * 8), s1 = *(GL_LAS const f32x4*)(ssb + i * 8 + 4);
              const float rstd = rsqrtf(((s0[0] + s0[1]) + (s0[2] + s0[3]) + (s1[0] + s1[1]) + (s1[2] + s1[3])) * (1.f / 128.f) + EPS);
              const float g = bf2f(R.g[it * 4 + r]);
              AO[(row0 + i) * 1024 + h * 128 + v] = (bf16_t)f2bf(o[it][r] * rstd * gn * g * __builtin_amdgcn_rcpf(1.f + __expf(-g))); } }
    __syncthreads();
}
constexpr int SM_Z = 0, SM_TOT = 4096, SM_SS = 6144;
__device__ __forceinline__ void c_load_vsz(UnitIn& R, int ch, const bf16_t* P, const bf16_t* SP, const float* DECp, int tid) {
    const int bh = ch >> 7, n = ch & 127, b = bh >> 2, h = bh & 3; const size_t row0 = (size_t)b * S + n * 64;
#pragma unroll
    for (int u = 0; u < 2; ++u) { const int c = tid + 512 * u, row = c >> 4, chn = c & 15;
        R.v[u] = *(const u32x4*)(P + (row0 + row) * NPROJ + PC_VG + h * 128 + chn * 8); }
    { const int lane = tid & 63, wave = tid >> 6, mt = wave & 3, ng = wave >> 2, fr = lane & 15, fq = lane >> 4;
      (void)SP; (void)ng; (void)fq;
      R.dk = DECp[(size_t)ch * 64 + 16 * mt + fr]; }
}
__device__ __forceinline__ void c_load_qk(UnitIn& R, int ch, const bf16_t* P, const float* BCS, int wave, int lane) {
    (void)P;
#pragma unroll
    for (int i = 0; i < 8; ++i) R.qk[i] = ((const unsigned*)BCS)[((size_t)ch * 64 + 8 * wave + i) * 64 + lane];
}
__device__ __forceinline__ void c_load_g(UnitIn& R, int ch, const bf16_t* P, int wave, int lane) {
    const int bh = ch >> 7, n = ch & 127, b = bh >> 2, h = bh & 3; const size_t row0 = (size_t)b * S + n * 64; const int fr = lane & 15, fq = lane >> 4, it = wave & 3, half = wave >> 2;
#pragma unroll
    for (int t = 0; t < 4; ++t) R.gp[t] = *(const uint2*)(P + (row0 + 16 * it + fr) * NPROJ + PC_GG + h * 128 + 64 * half + 16 * t + 4 * fq);
}
__device__ __forceinline__ void c_s1(GL_LAS unsigned char* img, const UnitIn& R, int tid) {
#pragma unroll
    for (int u = 0; u < 2; ++u) { const int c = tid + 512 * u, row = c >> 4, chn = c & 15;
        *(GL_LAS u32x4*)(img + L_B + row * BST + chn * 16) = R.v[u]; }
}
__device__ __forceinline__ void c_sS(GL_LAS unsigned char* img, const f32x4 (&St)[4], int tid) {
    const int lane = tid & 63, wave = tid >> 6, mt = wave & 3, ng = wave >> 2, fr = lane & 15, fq = lane >> 4;
#pragma unroll
    for (int t = 0; t < 4; ++t) { typedef unsigned gu32x2 __attribute__((ext_vector_type(2))); const gu32x2 w = (gu32x2){pk2(St[t][0], St[t][1]), pk2(St[t][2], St[t][3])};
        *(GL_LAS gu32x2*)(img + L_B + (64 + 16 * mt + fr) * BST + (16 * (ng * 4 + t) + 4 * fq) * 2) = w; }
}
__device__ __forceinline__ void c_kv(GL_LAS unsigned char* img, int wave, int lane, f32x4 (&acc)[4]) {
    const int mt = wave & 3, ng = wave >> 2, fr = lane & 15, fq = lane >> 4, q = fr >> 2, p = fr & 3;
#pragma unroll
    for (int t = 0; t < 4; ++t) acc[t] = (f32x4){0.f, 0.f, 0.f, 0.f};
#pragma unroll
    for (int ks = 0; ks < 2; ++ks) { GL_LAS const unsigned char* ap = img + L_K + (32 * ks + 8 * fq + q) * KST + (16 * mt + 4 * p) * 2;
        const s16x4 alo = tr4(ap), ahi = tr4(ap + 4 * KST);
        const bf16x8 a = (bf16x8){alo[0], alo[1], alo[2], alo[3], ahi[0], ahi[1], ahi[2], ahi[3]};
#pragma unroll
        for (int t = 0; t < 4; ++t) { const int nt = ng * 4 + t; GL_LAS const unsigned char* bp = img + L_B + (32 * ks + 8 * fq + q) * BST + (16 * nt + 4 * p) * 2;
            const s16x4 lo = tr4(bp), hi = tr4(bp + 4 * BST);
            const bf16x8 bb = (bf16x8){lo[0], lo[1], lo[2], lo[3], hi[0], hi[1], hi[2], hi[3]};
            acc[t] = __builtin_amdgcn_mfma_f32_16x16x32_bf16(bb, a, acc[t], 0, 0, 0); } }
}
__device__ __forceinline__ void c_adv(f32x4 (&Sn)[4], const f32x4 (&Sp)[4], const f32x4 (&kvr)[4], float dk) {
#pragma unroll
    for (int t = 0; t < 4; ++t) Sn[t] = (Sp[t] + kvr[t]) * dk;
}
__device__ __forceinline__ void c_s3(GL_LAS unsigned char* img, const UnitIn& R, int wave, int lane) {
#pragma unroll
    for (int i = 0; i < 8; ++i) { const int t = 8 * wave + i;
        *(GL_LAS bf16_t*)(img + L_A + t * AST + (64 + lane) * 2) = (bf16_t)(R.qk[i] & 0xffffu);
        *(GL_LAS bf16_t*)(img + L_K + t * KST + lane * 2) = (bf16_t)(R.qk[i] >> 16); }
}
__device__ __forceinline__ void c_s4(GL_LAS unsigned char* img, int wave, int lane) {
    const int fr = lane & 15, fq = lane >> 4; const int it = wave >> 1;
#pragma unroll
    for (int u = 0; u < 2; ++u) { const int jt = 2 * (wave & 1) + u;
        f32x4 acc = (f32x4){0.f, 0.f, 0.f, 0.f};
        if (jt <= it) {
#pragma unroll
            for (int ks = 0; ks < 2; ++ks) {
                const bf16x8 a = *(GL_LAS const bf16x8*)(img + L_A + (16 * it + fr) * AST + (64 + 32 * ks + 8 * fq) * 2);
                const bf16x8 bb = *(GL_LAS const bf16x8*)(img + L_K + (16 * jt + fr) * KST + (32 * ks + 8 * fq) * 2);
                acc = __builtin_amdgcn_mfma_f32_16x16x32_bf16(a, bb, acc, 0, 0, 0); } }
#pragma unroll
        for (int r = 0; r < 4; ++r) { const int i = 16 * it + 4 * fq + r, j = 16 * jt + fr;
            *(GL_LAS bf16_t*)(img + L_A + i * AST + j * 2) = (bf16_t)f2bf(j <= i ? acc[r] : 0.f); } }
}
__device__ __forceinline__ void c_s5(GL_LAS unsigned char* img, GL_LAS unsigned char* sm, int wave, int lane, f32x4 (&o)[4]) {
    const int fr = lane & 15, fq = lane >> 4, q = fr >> 2, p = fr & 3, it = wave & 3, half = wave >> 2;
#pragma unroll
    for (int t = 0; t < 4; ++t) o[t] = (f32x4){0.f, 0.f, 0.f, 0.f};
#pragma unroll
    for (int ks = 0; ks < 4; ++ks) { const bf16x8 a = *(GL_LAS const bf16x8*)(img + L_A + (16 * it + fr) * AST + (32 * ks + 8 * fq) * 2);
#pragma unroll
        for (int t = 0; t < 4; ++t) { GL_LAS const unsigned char* bp = img + L_B + (32 * ks + 8 * fq + q) * BST + (16 * (4 * half + t) + 4 * p) * 2;
            const s16x4 lo = tr4(bp), hi = tr4(bp + 4 * BST);
            const bf16x8 bb = (bf16x8){lo[0], lo[1], lo[2], lo[3], hi[0], hi[1], hi[2], hi[3]};
            o[t] = __builtin_amdgcn_mfma_f32_16x16x32_bf16(bb, a, o[t], 0, 0, 0); } }
    GL_LAS float* ssb = (GL_LAS float*)(sm + SM_SS);
    float s = 0.f;
#pragma unroll
    for (int t = 0; t < 4; ++t) s += (o[t][0] * o[t][0] + o[t][1] * o[t][1]) + (o[t][2] * o[t][2] + o[t][3] * o[t][3]);
    s += __shfl_xor(s, 16); s += __shfl_xor(s, 32);
    if (fq == 0) ssb[(16 * it + fr) * 8 + half] = s;
}
__device__ __forceinline__ void c_s6(GL_LAS unsigned char* sm, int ch, const UnitIn& R, const float* gain, bf16_t* AO, int wave, int lane, const f32x4 (&o)[4]) {
    const int bh = ch >> 7, n = ch & 127, b = bh >> 2, h = bh & 3; const size_t row0 = (size_t)b * S + n * 64;
    const int fr = lane & 15, fq = lane >> 4, it = wave & 3, half = wave >> 2; GL_LAS const float* ssb = (GL_LAS const float*)(sm + SM_SS);
    const int i = 16 * it + fr;
    const float rstd = rsqrtf((ssb[i * 8] + ssb[i * 8 + 1]) * (1.f / 128.f) + EPS);
#pragma unroll
    for (int t = 0; t < 4; ++t) { const int v = 64 * half + 16 * t + 4 * fq; const f32x4 gn = *(const f32x4*)(gain + h * 128 + v);
        const float g0 = bf2f(R.gp[t].x & 0xffffu), g1 = bf2f(R.gp[t].x >> 16), g2 = bf2f(R.gp[t].y & 0xffffu), g3 = bf2f(R.gp[t].y >> 16);
        uint2 w;
        w.x = pk2(o[t][0] * rstd * gn[0] * g0 * __builtin_amdgcn_rcpf(1.f + __expf(-g0)), o[t][1] * rstd * gn[1] * g1 * __builtin_amdgcn_rcpf(1.f + __expf(-g1)));
        w.y = pk2(o[t][2] * rstd * gn[2] * g2 * __builtin_amdgcn_rcpf(1.f + __expf(-g2)), o[t][3] * rstd * gn[3] * g3 * __builtin_amdgcn_rcpf(1.f + __expf(-g3)));
        *(uint2*)(AO + (row0 + i) * 1024 + h * 128 + v) = w; }
}
__device__ __forceinline__ void compose_start(int ch0, const float* SSEGp, const float* DSEGp, float* SSTp) {
    int tid = threadIdx.x; asm volatile("" : "+v"(tid)); const int lane = tid & 63, wave = tid >> 6;
    const int seg = ch0 >> 3, j0 = seg & ~15, mt = wave & 3, ng = wave >> 2, fr = lane & 15, fq = lane >> 4;
    const float* ssb = SSEGp + (16 * mt + fr) * 128 + 16 * (ng * 4) + 4 * fq; const float* dsb = DSEGp + 16 * mt + fr;
    f32x4 St[4];
#pragma unroll
    for (int t = 0; t < 4; ++t) St[t] = (f32x4){0.f, 0.f, 0.f, 0.f};
#pragma unroll 1
    for (int j = j0; j < seg; j += 4) { f32x4 sv[4][4]; float dv[4];
#pragma unroll
        for (int u = 0; u < 4; ++u) { const int jj = j + u < seg ? j + u : j; dv[u] = dsb[jj * 64];
#pragma unroll
            for (int t = 0; t < 4; ++t) sv[u][t] = *(const f32x4*)(ssb + (size_t)jj * 8192 + 16 * t); }
#pragma unroll
        for (int u = 0; u < 4; ++u) if (j + u < seg) {
#pragma unroll
            for (int t = 0; t < 4; ++t) St[t] = St[t] * dv[u] + sv[u][t]; } }
#pragma unroll
    for (int t = 0; t < 4; ++t) *(f32x4*)(SSTp + (size_t)seg * 8192 + (16 * mt + fr) * 128 + 16 * (ng * 4 + t) + 4 * fq) = St[t];
}
__device__ __forceinline__ void run_pairs_c(GL_LAS unsigned char* lds, int sm1_off, int ch0, int nunits, const bf16_t* P, const bf16_t* SP, const float* BCS, const float* gain, bf16_t* AO, const float* DECp, const float* SST) {
    const int tid = threadIdx.x, lane = tid & 63, wave = __builtin_amdgcn_readfirstlane(tid >> 6);
    GL_LAS unsigned char* const img0 = lds; GL_LAS unsigned char* const img1 = lds + 61440;
    GL_LAS unsigned char* const sm0 = lds + 122880; GL_LAS unsigned char* const sm1 = lds + sm1_off;
    f32x4 St[4], S1[4];
    { int t_ = threadIdx.x; asm volatile("" : "+v"(t_)); const int l_ = t_ & 63, w_ = t_ >> 6; const int seg = ch0 >> 3, mt = w_ & 3, ng = w_ >> 2, fr = l_ & 15, fq = l_ >> 4;
#pragma unroll
      for (int t = 0; t < 4; ++t) St[t] = *(const f32x4*)(SST + (size_t)seg * 8192 + (16 * mt + fr) * 128 + 16 * (ng * 4 + t) + 4 * fq); }
    UnitIn R0, R1;
    c_load_vsz(R0, ch0, P, SP, DECp, tid); c_load_vsz(R1, ch0 + 1, P, SP, DECp, tid);
    c_load_qk(R0, ch0, P, BCS, wave, lane); c_load_qk(R1, ch0 + 1, P, BCS, wave, lane);
    c_load_g(R0, ch0, P, wave, lane); c_load_g(R1, ch0 + 1, P, wave, lane);
    asm volatile("" ::: "memory");
#pragma unroll 1
    for (int i = 0; i < nunits; i += 2) {
        const int ca = ch0 + i, cn = ch0 + (i + 2 < nunits ? i + 2 : i);
        f32x4 o0[4], o1[4];
        c_s1(img0, R0, tid); c_s1(img1, R1, tid);
        c_s3(img0, R0, wave, lane); c_s3(img1, R1, wave, lane);
        const float dk0 = R0.dk, dk1 = R1.dk;
        asm volatile("" ::: "memory");
        c_load_vsz(R0, cn, P, SP, DECp, tid); c_load_vsz(R1, cn + 1, P, SP, DECp, tid);
        c_load_qk(R0, cn, P, BCS, wave, lane); c_load_qk(R1, cn + 1, P, BCS, wave, lane);
        asm volatile("" ::: "memory");
        __syncthreads();
        c_s4(img0, wave, lane); c_s4(img1, wave, lane);
        { f32x4 kvr[4];
          c_kv(img0, wave, lane, kvr); c_sS(img0, St, tid); c_adv(S1, St, kvr, dk0);
          c_kv(img1, wave, lane, kvr); c_sS(img1, S1, tid); c_adv(St, S1, kvr, dk1); }
        __syncthreads();
        c_s5(img0, sm0, wave, lane, o0); c_s5(img1, sm1, wave, lane, o1);
        __syncthreads();
        c_s6(sm0, ca, R0, gain, AO, wave, lane, o0); c_s6(sm1, ca + 1, R1, gain, AO, wave, lane, o1);
        asm volatile("" ::: "memory");
        c_load_g(R0, cn, P, wave, lane); c_load_g(R1, cn + 1, P, wave, lane);
        asm volatile("" ::: "memory");
        __syncthreads();
    }
}
template <bool PC>
__device__ __forceinline__ void run_units(GL_LAS unsigned char* lds, int ch0, int nunits, const bf16_t* P, const float* ZF, const float* w_gk2, const float* b_gk, const bf16_t* SP, const float* gain, float* KV, float* DEC, bf16_t* AO, float* BCS, float* SSEG = nullptr, float* DSEG = nullptr) {
    const int tid = threadIdx.x, lane = tid & 63, wave = __builtin_amdgcn_readfirstlane(tid >> 6);
    const int h = (ch0 >> 7) & 3;
    f32x4 Sseg[4]; float Dseg = 1.f;
#pragma unroll
    for (int t = 0; t < 4; ++t) Sseg[t] = (f32x4){0.f, 0.f, 0.f, 0.f};
    float wk[16];
#pragma unroll
    for (int r = 0; r < 16; ++r) wk[r] = w_gk2[r * 256 + h * 64 + lane];
    const float bk = b_gk[h * 64 + lane];
    UnitIn RA, RB;
    unit_load<PC>(RA, ch0, P, ZF, SP, tid, wave, lane);
#pragma unroll 1
    for (int i = 0; i < nunits; i += 2) {
        unit_load<PC>(RB, ch0 + i + 1, P, ZF, SP, tid, wave, lane);
        if (PC) phase_c_unit(lds, ch0 + i, RA, wk, bk, gain, AO); else phase_a_unit(lds, ch0 + i, RA, wk, bk, KV, DEC, BCS, Sseg, Dseg);
        unit_load<PC>(RA, ch0 + (i + 2 < nunits ? i + 2 : i), P, ZF, SP, tid, wave, lane);
        if (PC) phase_c_unit(lds, ch0 + i + 1, RB, wk, bk, gain, AO); else phase_a_unit(lds, ch0 + i + 1, RB, wk, bk, KV, DEC, BCS, Sseg, Dseg);
    }
    if (!PC) { const int seg = ch0 >> 3, mt = wave & 3, ng = wave >> 2, fr = lane & 15, fq = lane >> 4;
#pragma unroll
        for (int t = 0; t < 4; ++t) *(f32x4*)(SSEG + (size_t)seg * 8192 + (16 * mt + fr) * 128 + 16 * (ng * 4 + t) + 4 * fq) = Sseg[t];
        if (fq == 0 && ng == 0) DSEG[seg * 64 + 16 * mt + fr] = Dseg; }
}
#undef GL_LAS
}

#define LAS __attribute__((address_space(3)))
constexpr int NWAVES = 8, NTHR = 512;
constexpr int RING_BYTES = 131072, LDS_BYTES = 163840;
constexpr size_t WS_WINT = WS_END;
constexpr size_t WS_WOT = WS_WINT + 8 * MiB;
constexpr size_t WS_W1T = WS_WOT + 2 * MiB;
constexpr size_t WS_W2T = WS_W1T + 128 * MiB;
constexpr size_t WS_END2 = WS_W2T + 64 * MiB;
constexpr size_t WS_SLOTE = WS_W1T + 64 * MiB;
constexpr size_t WS_KV = WS_YS;
constexpr size_t WS_BCS = WS_YS + 32 * MiB;
constexpr size_t WS_SP = WS_YS + 64 * MiB;
constexpr size_t WS_SSEG = WS_SP;
constexpr size_t WS_SST = WS_SP + 8 * MiB;
constexpr size_t WS_DSEG = WS_SP + 16 * MiB;
constexpr size_t WS_DEC = WS_YS + 96 * MiB;
constexpr size_t WS_LF = WS_YS + 97 * MiB;
constexpr size_t WS_SEGT = WS_YS + 98 * MiB;
constexpr size_t WS_UDMIN = WS_YS + 99 * MiB;

enum Phase { PH_PRO = 0, PH_XN = 1, PH_G1 = 2, PH_GLAA = 3, PH_SCAN = 4, PH_ATTN = 5, PH_WO = 6, PH_ROUTE = 7, PH_PLAN = 8, PH_E1 = 9, PH_E2 = 10, PH_FINAL = 11, PH_COUNT = 12 };

#define RLX_AGENT __ATOMIC_RELAXED, __HIP_MEMORY_SCOPE_AGENT
#define XB_TMO      128
#define XB_XCNT(j)  (256  + 64 * (j))
#define XB_XSUB(j)  (1280 + 64 * (j))
#define XB_XGEN(j)  (2304 + 64 * (j))
#define XB_TOP      3328
#define XB_TOPGEN   3392
#define XCD_BAR_WORDS 3456
#define XB_SPIN_CAP (1u << 18)
constexpr int CW_BAR = 4096;
constexpr int LDSCTL_OFF = RING_BYTES, MISC_OFF = LDSCTL_OFF + 320;
__device__ __forceinline__ unsigned xb_ld(unsigned* p)              { return __hip_atomic_load(p, __ATOMIC_RELAXED, __HIP_MEMORY_SCOPE_AGENT); }
__device__ __forceinline__ unsigned xb_add(unsigned* p, unsigned v) { return __hip_atomic_fetch_add(p, v, __ATOMIC_RELAXED, __HIP_MEMORY_SCOPE_AGENT); }
__device__ __forceinline__ unsigned xb_xcc_id() { return (unsigned)__builtin_amdgcn_s_getreg((3 << 11) | 20) & 0xFu; }
#define XB_SPIN(cond, bar) do { unsigned _sp = 0; while (cond) { __builtin_amdgcn_s_sleep(1); \
    if ((++_sp & 255u) == 0u) { if (xb_ld(&(bar)[XB_TMO])) break; if (_sp > XB_SPIN_CAP) { atomicAdd(&(bar)[XB_TMO], 1u); break; } } } } while (0)
struct XcdBarrier { unsigned* bar; unsigned x; volatile LAS unsigned* st; };
__device__ __forceinline__ XcdBarrier xcd_barrier_post(unsigned* bar, volatile LAS unsigned* st) {
    XcdBarrier b; b.bar = bar; b.x = xb_xcc_id(); b.st = st;
    if (threadIdx.x == 0) (void)xb_add(&bar[XB_XCNT(b.x)], 1u);
    return b;
}
__device__ __forceinline__ void xcd_barrier_complete(unsigned* bar, unsigned x, unsigned& nloc, unsigned& nx) {
    const unsigned G = gridDim.x * gridDim.y * gridDim.z;
    unsigned sum, cnt, mine, sp = 0u;
    for (;;) {
        sum = 0u; cnt = 0u; mine = 0u;
#pragma unroll
        for (unsigned j = 0; j < 16; ++j) { const unsigned c = xb_ld(&bar[XB_XCNT(j)]); sum += c; cnt += (c > 0u) ? 1u : 0u; mine = (j == x) ? c : mine; }
        if (sum == G) break;
        __builtin_amdgcn_s_sleep(1);
        if ((++sp & 255u) == 0u) { if (xb_ld(&bar[XB_TMO])) break; if (sp > XB_SPIN_CAP) { atomicAdd(&bar[XB_TMO], 1u); break; } }
    }
    nloc = mine > 0u ? mine : 1u; nx = cnt > 0u ? cnt : 1u;
}
__device__ __forceinline__ void xcd_barrier(const XcdBarrier& b) {
    asm volatile("s_waitcnt vmcnt(0)" ::: "memory");
    __syncthreads();
    if (threadIdx.x == 0) {
        unsigned* bar = b.bar;
        __builtin_amdgcn_s_waitcnt(0);
        unsigned nloc = b.st[0], nx = b.st[1];
        if (nloc == 0u) { xcd_barrier_complete(bar, b.x, nloc, nx); b.st[0] = nloc; b.st[1] = nx; }
        const unsigned old = xb_add(&bar[XB_XSUB(b.x)], 1u);
        const unsigned gen = old / nloc;
        if (old + 1u == (gen + 1u) * nloc) {
            __builtin_amdgcn_fence(__ATOMIC_RELEASE, "agent");
            asm volatile("s_waitcnt vmcnt(0)" ::: "memory");
            (void)xb_add(&bar[XB_TOP], 1u);
        }
        XB_SPIN(xb_ld(&bar[XB_TOP]) < (gen + 1u) * nx, bar);
        __builtin_amdgcn_fence(__ATOMIC_ACQUIRE, "agent");
        asm volatile("s_waitcnt vmcnt(0)" ::: "memory");
    }
    __syncthreads();
}

struct Args {
    const float* in[20]; float* out; unsigned char* ws; int ph_lo, ph_hi;
};

__device__ __forceinline__ int map_in(int c) {
    if (c < 256) return PC_QG + c; if (c < 512) return PC_KG + c - 256; if (c < 1024) return PC_VG + c - 512; if (c < 1536) return PC_GG + c - 1024;
    if (c < 1552) return 3072 + c - 1536; if (c < 2064) return PC_QF + c - 1552; if (c < 2576) return PC_KF + c - 2064; if (c < 3088) return PC_VF + c - 2576;
    return 3088 + c - 3088;
}
__device__ __forceinline__ int map_e1(int c) { return ((c & 1023) >> 7) * 256 + (c >> 10) * 128 + (c & 127); }
struct TrItem { const float* W; unsigned char* WT; int N, kbp, nb, map, fp8; };
typedef float tr_f32x4 __attribute__((ext_vector_type(4)));
__device__ __forceinline__ TrItem tr_decode(int it, const Args& args, bf16_t* WINT, bf16_t* WOT, unsigned char* W1F, unsigned char* W2F) {
    constexpr int I_IN = 8 * 97, I_O = 8 * 32, I_E1 = 8 * 64, I_E2 = 8 * 32;
    TrItem d; int r = it;
    if (r < I_IN) { d.W = args.in[6]; d.WT = (unsigned char*)WINT; d.N = 3096; d.kbp = r / 97; d.nb = r % 97; d.map = 1; d.fp8 = 0; return d; } r -= I_IN;
    if (r < I_O) { d.W = args.in[11]; d.WT = (unsigned char*)WOT; d.N = 1024; d.kbp = r / 32; d.nb = r % 32; d.map = 0; d.fp8 = 0; return d; } r -= I_O;
    if (r < NE * I_E1) { const int e = r / I_E1, q = r % I_E1; d.W = args.in[16] + (size_t)e * 1024 * 2048; d.WT = W1F + (size_t)e * 2048 * 1024; d.N = 2048; d.kbp = q / 64; d.nb = q % 64; d.map = 2; d.fp8 = 1; return d; } r -= NE * I_E1;
    { const int e = r / I_E2, q = r % I_E2; d.W = args.in[18] + (size_t)e * 1024 * 1024; d.WT = W2F + (size_t)e * 1024 * 1024; d.N = 1024; d.kbp = q / 32; d.nb = q % 32; d.map = 0; d.fp8 = 1; return d; }
}
constexpr int TR_NITEMS = 8 * 97 + 8 * 32 + 24 * 8 * 64;
__device__ __forceinline__ void tr_load(tr_f32x4 (&v)[8], const TrItem& d, int sub, int lane) {
    const int k0 = 64 * (2 * d.kbp + sub), n = 32 * d.nb + (lane & 7) * 4, kr = lane >> 3; const bool ok = n < d.N;
#pragma unroll
    for (int i = 0; i < 8; ++i) v[i] = ok ? __builtin_nontemporal_load((const tr_f32x4*)(d.W + (size_t)(k0 + 8 * kr + i) * d.N + n)) : (tr_f32x4){0.f, 0.f, 0.f, 0.f};
    asm volatile("" ::: "memory");
}
__device__ __forceinline__ void tr_process(const tr_f32x4 (&v)[8], const TrItem& d, int sub, LAS float* scr, int lane) {
    (void)scr;
    const int k0 = 64 * (2 * d.kbp + sub), n0 = 32 * d.nb + (lane & 7) * 4, kr = lane >> 3;
#pragma unroll
    for (int c = 0; c < 4; ++c) { const int col = n0 + c;
        const int drow = col < d.N ? (d.map == 0 ? col : (d.map == 1 ? map_in(col) : map_e1(col))) : 4096;
        if (drow < 3072) {
            if (d.fp8) { uint2 o; o.x = pk4_fp8(v[0][c] * WSCALE, v[1][c] * WSCALE, v[2][c] * WSCALE, v[3][c] * WSCALE); o.y = pk4_fp8(v[4][c] * WSCALE, v[5][c] * WSCALE, v[6][c] * WSCALE, v[7][c] * WSCALE);
                *(uint2*)(d.WT + (size_t)drow * 1024 + k0 + 8 * kr) = o; }
            else { uint4 o; o.x = pk2(v[0][c], v[1][c]); o.y = pk2(v[2][c], v[3][c]); o.z = pk2(v[4][c], v[5][c]); o.w = pk2(v[6][c], v[7][c]);
                *(uint4*)((bf16_t*)d.WT + (size_t)drow * 1024 + k0 + 8 * kr) = o; } } }
}

__global__ void __launch_bounds__(NTHR, 2) mk_fwd(Args args) {
    extern __shared__ __attribute__((aligned(16))) unsigned char lds_raw[];
    LAS unsigned char* lds = (LAS unsigned char*)lds_raw;
    const int tid = threadIdx.x, lane = tid & 63, wave = __builtin_amdgcn_readfirstlane(tid >> 6);
    const int G = gridDim.x, bx = blockIdx.x;
    const int vcu = (G % 8 == 0) ? (bx % 8) * (G / 8) + bx / 8 : bx;
    unsigned char* ws = args.ws;
    int* ctl = (int*)(ws + WS_CTL);
    float* mod = (float*)(ws + WS_MOD);
#define MODV(b, n) ((((args.in[3][n] + mod[(0 * 4 + (b)) * 6144 + (n)]) + mod[(1 * 4 + (b)) * 6144 + (n)]) + mod[(2 * 4 + (b)) * 6144 + (n)]) + mod[(3 * 4 + (b)) * 6144 + (n)])
    bf16_t* XN = (bf16_t*)(ws + WS_XN); bf16_t* PROJ = (bf16_t*)(ws + WS_PROJ); bf16_t* AO = (bf16_t*)(ws + WS_AO); float* Y = (float*)(ws + WS_Y);
    bf16_t* ACT = (bf16_t*)(ws + WS_ACT); bf16_t* YS = (bf16_t*)(ws + WS_YS); float* ZF = (float*)(ws + WS_ZF);
    bf16_t* WINT = (bf16_t*)(ws + WS_WINT); bf16_t* WOT = (bf16_t*)(ws + WS_WOT); bf16_t* W1T = (bf16_t*)(ws + WS_W1T); bf16_t* W2T = (bf16_t*)(ws + WS_W2T);
    const int lo = args.ph_lo, hi = args.ph_hi;
#define IN(k) (lo <= (k) && (k) < hi)
#define SEAM(k) do { if (IN(k) && IN((k) + 1)) xcd_barrier(bar); } while (0)
    { int u0 = tid; asm volatile("" : "+v"(u0));
      for (int u = u0; u < (LDS_BYTES - LDSCTL_OFF) / 4; u += NTHR) ((LAS unsigned*)(lds + LDSCTL_OFF))[u] = 0u; }
    __syncthreads();
    XcdBarrier bar; bar.bar = (unsigned*)ctl + CW_BAR; bar.x = 0; bar.st = nullptr;
    if (hi - lo > 1) bar = xcd_barrier_post((unsigned*)ctl + CW_BAR, (volatile LAS unsigned*)(lds + MISC_OFF) + 8);
    const int gw = vcu * NWAVES + wave, NGW = G * NWAVES;

    if (IN(PH_PRO)) {
        const float* c = args.in[1]; const float* w_ada = args.in[2]; const float* b_ada = args.in[3];
        typedef float f32x4 __attribute__((ext_vector_type(4)));
        { LAS float* sc = (LAS float*)lds;
          LAS float* red = (LAS float*)(lds + 16384);
          const int cg = bx >> 2, kq = bx & 3;
          { int i0 = tid; asm volatile("" : "+v"(i0)); for (int i = i0; i < 1024; i += NTHR) sc[i] = silu_f(c[(i >> 8) * 1024 + 256 * kq + (i & 255)]); }
          __syncthreads();
          { const int kk = tid / 24, c4 = tid % 24, n0 = cg * 96;
            f32x4 wv[13];
#pragma unroll
            for (int j = 0; j < 13; ++j) { const int r = kk + 21 * j; wv[j] = (tid < 504 && r < 256) ? __builtin_nontemporal_load((const f32x4*)(w_ada + (size_t)(256 * kq + r) * 6144 + n0 + 4 * c4)) : (f32x4){0.f, 0.f, 0.f, 0.f}; }
            f32x4 a0 = (f32x4){0.f, 0.f, 0.f, 0.f}, a1 = a0, a2 = a0, a3 = a0;
#pragma unroll
            for (int j = 0; j < 13; ++j) { const int r = kk + 21 * j; if (r < 256) { a0 += wv[j] * sc[r]; a1 += wv[j] * sc[256 + r]; a2 += wv[j] * sc[512 + r]; a3 += wv[j] * sc[768 + r]; } }
            if (tid < 504) { LAS float* rp = red + kk * 384 + 4 * c4; *(LAS f32x4*)(rp) = a0; *(LAS f32x4*)(rp + 96) = a1; *(LAS f32x4*)(rp + 192) = a2; *(LAS f32x4*)(rp + 288) = a3; } }
          __syncthreads();
          if (tid < 384) { const int b = tid / 96, nl = tid % 96; float s_ = 0.f;
#pragma unroll
              for (int kk = 0; kk < 21; ++kk) s_ += red[kk * 384 + b * 96 + nl];
              mod[(kq * 4 + b) * 6144 + cg * 96 + nl] = s_; }
          __syncthreads(); }
        { LAS float* scr = (LAS float*)(lds + wave * 16384);
          unsigned char* W1F = (unsigned char*)W1T; unsigned char* W2F = (unsigned char*)W2T;
          tr_f32x4 vA[8], vB[8];
          int it = gw;
          if (it < TR_NITEMS) {
              TrItem d = tr_decode(it, args, WINT, WOT, W1F, W2F);
              tr_load(vA, d, 0, lane);
#pragma unroll 1
              for (;;) {
                  tr_load(vB, d, 1, lane);
                  tr_process(vA, d, 0, scr, lane);
                  const int itn = it + NGW; const bool more = itn < TR_NITEMS;
                  const TrItem dn = tr_decode(more ? itn : it, args, WINT, WOT, W1F, W2F);
                  if (more) tr_load(vA, dn, 0, lane);
                  tr_process(vB, d, 1, scr, lane);
                  if (!more) break;
                  it = itn; d = dn;
              } } }
    }
    SEAM(PH_PRO);
    if (IN(PH_XN)) {
        typedef float f32x4 __attribute__((ext_vector_type(4)));
        const float* x = args.in[0]; const float* gain = args.in[4]; const float* w_in = args.in[6];
        constexpr int HTB = 2064;
        typedef short xbf16x8 __attribute__((ext_vector_type(8))); typedef unsigned xu32x4 __attribute__((ext_vector_type(4))); typedef unsigned xu32x2 __attribute__((ext_vector_type(2)));
        LAS unsigned char* HTH = lds; LAS unsigned char* HTL = lds + 16 * HTB; LAS float* PART = (LAS float*)(lds + 66048);
        LAS float* PA = (LAS float*)(lds + 82432); LAS float* PB = PA + 1024;
        { const int b0 = (128 * bx) / S;
          int c0 = tid; asm volatile("" : "+v"(c0)); for (int c = c0; c < 1024; c += NTHR) { PA[c] = gain[c] * (1.f + MODV(b0, 1024 + c)); PB[c] = MODV(b0, c); } }
        __syncthreads();
        const int fr = lane & 15, fq = lane >> 4;
        xbf16x8 bh[4][2], bl[4][2];
#pragma unroll
        for (int s2 = 0; s2 < 4; ++s2)
#pragma unroll
            for (int nt = 0; nt < 2; ++nt) { float wv[8];
#pragma unroll
                for (int i = 0; i < 8; ++i) { const size_t kr = (size_t)(128 * wave + 32 * s2 + 8 * fq + i) * 3096; wv[i] = nt == 0 ? w_in[kr + 1536 + fr] : (fr < 8 ? w_in[kr + 3088 + fr] : 0.f); }
                bh[s2][nt] = __builtin_bit_cast(xbf16x8, (xu32x4){pk_hi(wv[0], wv[1]), pk_hi(wv[2], wv[3]), pk_hi(wv[4], wv[5]), pk_hi(wv[6], wv[7])});
                bl[s2][nt] = __builtin_bit_cast(xbf16x8, (xu32x4){pk_lo(wv[0], wv[1]), pk_lo(wv[2], wv[3]), pk_lo(wv[4], wv[5]), pk_lo(wv[6], wv[7])}); }
#define XN_LOAD(RX, p) do { _Pragma("unroll") for (int rr = 0; rr < 2; ++rr) { const int row_ = 128 * bx + 16 * (p) + 2 * wave + rr; \
            _Pragma("unroll") for (int j = 0; j < 4; ++j) { const f32x4 t_ = __builtin_nontemporal_load((const f32x4*)(x + (size_t)row_ * D) + lane + 64 * j); RX[rr][j] = make_float4(t_[0], t_[1], t_[2], t_[3]); } } asm volatile("" ::: "memory"); } while (0)
#define XN_PASS(RX, p) do { \
            _Pragma("unroll") for (int rr = 0; rr < 2; ++rr) { \
                const int rowl = 2 * wave + rr, row = 128 * bx + 16 * (p) + rowl; \
                float ss = 0.f; \
                _Pragma("unroll") for (int j = 0; j < 4; ++j) { const float4 v_ = RX[rr][j]; ss += v_.x * v_.x + v_.y * v_.y + v_.z * v_.z + v_.w * v_.w; } \
                const float rstd = rsqrtf(wave_sum(ss) * (1.f / D) + EPS); \
                _Pragma("unroll") for (int j = 0; j < 4; ++j) { const int col = 4 * lane + 256 * j; const float4 v_ = RX[rr][j]; \
                    const f32x4 pa = *(LAS const f32x4*)(PA + col), pb = *(LAS const f32x4*)(PB + col); \
                    f32x4 hv; hv[0] = v_.x * rstd * pa[0] + pb[0]; hv[1] = v_.y * rstd * pa[1] + pb[1]; \
                    hv[2] = v_.z * rstd * pa[2] + pb[2]; hv[3] = v_.w * rstd * pa[3] + pb[3]; \
                    uint2 w; w.x = pk2(hv[0], hv[1]); w.y = pk2(hv[2], hv[3]); \
                    *(uint2*)(XN + (size_t)row * D + col) = w; \
                    { const xu32x2 wh = (xu32x2){pk_hi(hv[0], hv[1]), pk_hi(hv[2], hv[3])}, wl = (xu32x2){pk_lo(hv[0], hv[1]), pk_lo(hv[2], hv[3])}; \
                      *(LAS xu32x2*)(HTH + rowl * HTB + col * 2) = wh; *(LAS xu32x2*)(HTL + rowl * HTB + col * 2) = wl; } } \
            } \
            __syncthreads(); \
            { f32x4 a0 = (f32x4){0.f, 0.f, 0.f, 0.f}, a1 = (f32x4){0.f, 0.f, 0.f, 0.f}; \
              xbf16x8 ah[4], al[4]; \
              _Pragma("unroll") for (int s2 = 0; s2 < 4; ++s2) { ah[s2] = *(LAS const xbf16x8*)(HTH + fr * HTB + (128 * wave + 32 * s2 + 8 * fq) * 2); al[s2] = *(LAS const xbf16x8*)(HTL + fr * HTB + (128 * wave + 32 * s2 + 8 * fq) * 2); } \
              asm volatile("s_waitcnt lgkmcnt(0)" ::: "memory"); __builtin_amdgcn_sched_barrier(0); \
              _Pragma("unroll") for (int s2 = 0; s2 < 4; ++s2) { \
                  a0 = __builtin_amdgcn_mfma_f32_16x16x32_bf16(ah[s2], bh[s2][0], a0, 0, 0, 0); a1 = __builtin_amdgcn_mfma_f32_16x16x32_bf16(ah[s2], bh[s2][1], a1, 0, 0, 0); \
                  a0 = __builtin_amdgcn_mfma_f32_16x16x32_bf16(ah[s2], bl[s2][0], a0, 0, 0, 0); a1 = __builtin_amdgcn_mfma_f32_16x16x32_bf16(ah[s2], bl[s2][1], a1, 0, 0, 0); \
                  a0 = __builtin_amdgcn_mfma_f32_16x16x32_bf16(al[s2], bh[s2][0], a0, 0, 0, 0); a1 = __builtin_amdgcn_mfma_f32_16x16x32_bf16(al[s2], bh[s2][1], a1, 0, 0, 0); } \
              _Pragma("unroll") for (int r = 0; r < 4; ++r) { PART[(wave * 16 + 4 * fq + r) * 32 + fr] = a0[r]; PART[(wave * 16 + 4 * fq + r) * 32 + 16 + fr] = a1[r]; } } \
            __syncthreads(); \
            { const int rowl = tid >> 5, n = tid & 31; float sum = 0.f; \
              _Pragma("unroll") for (int w2 = 0; w2 < 8; ++w2) sum += PART[(w2 * 16 + rowl) * 32 + n]; \
              unsigned zo = (unsigned)(128 * bx + 16 * (p) + rowl) * 32u + n; asm volatile("" : "+v"(zo)); ZF[zo] = sum; } \
        } while (0)
        { float4 xA[2][4], xB[2][4], xC[2][4];
          XN_LOAD(xA, 0); XN_LOAD(xB, 1);
          XN_LOAD(xC, 2); XN_PASS(xA, 0);
          XN_LOAD(xA, 3); XN_PASS(xB, 1);
          XN_LOAD(xB, 4); XN_PASS(xC, 2);
          XN_LOAD(xC, 5); XN_PASS(xA, 3);
          XN_LOAD(xA, 6); XN_PASS(xB, 4);
          XN_LOAD(xB, 7); XN_PASS(xC, 5);
          XN_PASS(xA, 6);
          XN_PASS(xB, 7); }
#undef XN_LOAD
#undef XN_PASS
    }
    SEAM(PH_XN);
    if (IN(PH_G1)) {
        pg8::Gemm g{XN, WINT, 1024, 0, nullptr}; pg8::Order O; O.init(M / 256, NPROJ / 256, G, bx, (const LAS int*)nullptr);
        pg8::EpiProj E{PROJ, ZF};
        pg8::gemm_phase<pg8::EpiProj, 0, false>(lds, g, O, E);
    }
    SEAM(PH_G1);
    float* KV = (float*)(ws + WS_KV); bf16_t* SP = (bf16_t*)(ws + WS_SP); float* DEC = (float*)(ws + WS_DEC); float* LF = (float*)(ws + WS_LF); float* SEGT = (float*)(ws + WS_SEGT);
    float* NF = (float*)(ws + WS_NF);
    if (IN(PH_GLAA)) {
        { const int bhf = bx >> 3, seg = bx & 7, b = bhf >> 3, hf = bhf & 7; const float bfv = args.in[10][hf];
          const int t0 = seg * 1024 + 2 * tid;
          const float l0 = logsigmoid_f(ZF[((size_t)b * S + t0) * 32 + 16 + hf] + bfv), l1 = logsigmoid_f(ZF[((size_t)b * S + t0 + 1) * 32 + 16 + hf] + bfv);
          const float c1 = l0 + l1; float sc = c1;
#pragma unroll
          for (int off = 1; off < 64; off <<= 1) { const float t = __shfl_up(sc, off); if (lane >= off) sc += t; }
          LAS float* wt = (LAS float*)(lds + gla::L_END);
          if (lane == 63) wt[wave] = sc;
          __syncthreads();
          float base = 0.f, total = 0.f;
#pragma unroll
          for (int w = 0; w < 8; ++w) { const float t = wt[w]; total += t; if (w < wave) base += t; }
          const float excl = base + sc - c1;
          LF[(size_t)bhf * S + t0] = excl + l0; LF[(size_t)bhf * S + t0 + 1] = excl + c1;
          if (tid == 0) SEGT[bhf * 8 + seg] = total;
          __syncthreads(); }
        gla::run_units<false>(lds, bx * 8, 8, PROJ, ZF, args.in[7], args.in[8], nullptr, nullptr, KV, DEC, nullptr, (float*)(ws + WS_BCS), (float*)(ws + WS_SSEG), (float*)(ws + WS_DSEG));
        __syncthreads();
        { const int bhf = bx >> 3, seg = bx & 7, b = bhf >> 3, hf = bhf & 7; float q2m = 0.f, k2m = 0.f, dmin = 3.0e38f;
#pragma unroll 1
          for (int i0 = 0; i0 < 16; i0 += 4) { uint4 qa[4], ka[4];
#pragma unroll
              for (int j = 0; j < 4; ++j) { const size_t row = (size_t)b * S + seg * 1024 + 128 * wave + 8 * (i0 + j) + (lane >> 3);
                  qa[j] = *(const uint4*)(PROJ + row * NPROJ + PC_QF + hf * 64 + (lane & 7) * 8); ka[j] = *(const uint4*)(PROJ + row * NPROJ + PC_KF + hf * 64 + (lane & 7) * 8); }
#pragma unroll
              for (int j = 0; j < 4; ++j) { const unsigned qw[4] = {qa[j].x, qa[j].y, qa[j].z, qa[j].w}, kw[4] = {ka[j].x, ka[j].y, ka[j].z, ka[j].w}; float q2 = 0.f, k2 = 0.f, dg = 0.f;
#pragma unroll
                  for (int i = 0; i < 4; ++i) { const float q0 = bf2f(qw[i] & 0xffffu), q1 = bf2f(qw[i] >> 16), k0 = bf2f(kw[i] & 0xffffu), k1 = bf2f(kw[i] >> 16); q2 += q0 * q0 + q1 * q1; k2 += k0 * k0 + k1 * k1; dg += q0 * k0 + q1 * k1; }
                  q2 += dpp_mov_f<0xB1>(q2); q2 += dpp_mov_f<0x4E>(q2); q2 += dpp_mov_f<0x141>(q2);
                  k2 += dpp_mov_f<0xB1>(k2); k2 += dpp_mov_f<0x4E>(k2); k2 += dpp_mov_f<0x141>(k2);
                  dg += dpp_mov_f<0xB1>(dg); dg += dpp_mov_f<0x4E>(dg); dg += dpp_mov_f<0x141>(dg);
                  q2m = fmaxf(q2m, q2); k2m = fmaxf(k2m, k2); dmin = fminf(dmin, dg); } }
#pragma unroll
          for (int o = 1; o < 64; o <<= 1) { q2m = fmaxf(q2m, __shfl_xor(q2m, o)); k2m = fmaxf(k2m, __shfl_xor(k2m, o)); dmin = fminf(dmin, __shfl_xor(dmin, o)); }
          LAS float* dml = (LAS float*)lds; if (lane == 0) { dml[wave] = dmin; dml[8 + wave] = q2m; }
          __syncthreads();
          if (tid < 4) { ((float*)(ws + WS_UDMIN))[bhf * 32 + seg * 4 + tid] = fminf(dml[2 * tid], dml[2 * tid + 1]);
              ((float*)(ws + WS_UDMIN))[1024 + bhf * 32 + seg * 4 + tid] = fmaxf(dml[8 + 2 * tid], dml[8 + 2 * tid + 1]); }
          if (lane == 0) { atomicMax((unsigned*)ctl + CW_QK2 + bhf, __float_as_uint(q2m)); atomicMax((unsigned*)ctl + CW_QK2 + 32 + bhf, __float_as_uint(k2m)); } }
    }
    SEAM(PH_GLAA);
    if (IN(PH_ATTN)) {
        gla::compose_start(bx * 8, (const float*)(ws + WS_SSEG), (const float*)(ws + WS_DSEG), (float*)(ws + WS_SST));
        static_assert(attn_body::ATTN_LDS_BYTES <= RING_BYTES, "attention LDS");
        const attn_body::AttnTensors AT{(const attn_body::bf16*)(PROJ + PC_QF), (const attn_body::bf16*)(PROJ + PC_KF), (const attn_body::bf16*)(PROJ + PC_VF), (attn_body::bf16*)(AO + 512), (const float*)LF, (const float*)SEGT, (const float*)(ws + WS_UDMIN), (const unsigned*)ctl + CW_QK2, args.in[16], (unsigned char*)W1T};
        static_assert(attn_body::ATT_TAB + 512 + 4096 + 4096 + 128 <= RING_BYTES, "attention tables");
        attn_body::attn_phase_queue<8>((char*)lds_raw, AT, (unsigned*)ctl + CW_AQ);
        __syncthreads();
        gla::run_pairs_c(lds, LDS_BYTES - 8192, bx * 8, 8, PROJ, (const bf16_t*)KV, (const float*)(ws + WS_BCS), args.in[9], AO, DEC, (const float*)(ws + WS_SST));
    }
    SEAM(PH_ATTN);
    if (IN(PH_WO)) {
        pg8::Gemm g{AO, WOT, 1024, 0, nullptr}; pg8::Order O; O.init(M / 256, 4, G, bx, (const LAS int*)nullptr);
        pg8::EpiBf16 E{(bf16_t*)Y, D};
        pg8::gemm_phase<pg8::EpiBf16, 0, false>(lds, g, O, E);
    }
    SEAM(PH_WO);
    int* TOPE = (int*)(ws + WS_TOPE); float* TOPG = (float*)(ws + WS_TOPG); int* RANK = (int*)(ws + WS_RANK); int* TPOS = (int*)(ws + WS_TPOS); int* SLOT = (int*)(ws + WS_SLOT);
    int* SLOTE = (int*)(ws + WS_SLOTE);
    if (IN(PH_ROUTE)) {
        typedef float f32x4 __attribute__((ext_vector_type(4)));
        const float* x = args.in[0]; const float* g_post = args.in[5]; const float* g_mpre = args.in[12]; const float* w_router = args.in[14]; const float* b_router = args.in[15];
        bf16_t* X1B = (bf16_t*)(ws + WS_X1B);
        constexpr int HTB = 2064;
        typedef short xbf16x8 __attribute__((ext_vector_type(8))); typedef unsigned xu32x4 __attribute__((ext_vector_type(4))); typedef unsigned xu32x2 __attribute__((ext_vector_type(2)));
        LAS unsigned char* HTH = lds; LAS unsigned char* HTL = lds + 16 * HTB; LAS float* PART = (LAS float*)(lds + 66048); LAS int* lcnt = (LAS int*)(lds + 98304 + 2304);
        LAS int* er_l = (LAS int*)(lds + 98304); LAS int* lbase = er_l + 512;
        if (tid < 32) lcnt[tid] = 0;
        LAS float* PA = (LAS float*)(lds + 82432); LAS float* PB = PA + 1024; LAS float* PC = PB + 1024;
        { const int b0 = (128 * bx) / S;
          int c0 = tid; asm volatile("" : "+v"(c0)); for (int c = c0; c < 1024; c += NTHR) { PA[c] = MODV(b0, 2048 + c) * g_post[c]; PB[c] = g_mpre[c] * (1.f + MODV(b0, 4096 + c)); PC[c] = MODV(b0, 3072 + c); } }
        unsigned char* H2F = (unsigned char*)XN;
        if (bx == 0 && tid < 256) ((unsigned*)(H2F + (size_t)M * D))[tid] = 0u;
        const int fr = lane & 15, fq = lane >> 4;
        xbf16x8 bh[4][2], bl[4][2];
#pragma unroll
        for (int s = 0; s < 4; ++s)
#pragma unroll
            for (int nt = 0; nt < 2; ++nt) { float wv[8];
#pragma unroll
                for (int i = 0; i < 8; ++i) wv[i] = w_router[(size_t)(128 * wave + 32 * s + 8 * fq + i) * 32 + 16 * nt + fr];
                bh[s][nt] = __builtin_bit_cast(xbf16x8, (xu32x4){pk_hi(wv[0], wv[1]), pk_hi(wv[2], wv[3]), pk_hi(wv[4], wv[5]), pk_hi(wv[6], wv[7])});
                bl[s][nt] = __builtin_bit_cast(xbf16x8, (xu32x4){pk_lo(wv[0], wv[1]), pk_lo(wv[2], wv[3]), pk_lo(wv[4], wv[5]), pk_lo(wv[6], wv[7])}); }
        __syncthreads();
#define ROUTE_LOAD(RX, RY, p) do { _Pragma("unroll") for (int rr = 0; rr < 2; ++rr) { const int row_ = 128 * bx + 16 * (p) + 2 * wave + rr; \
            _Pragma("unroll") for (int j = 0; j < 4; ++j) { RY[rr][j] = ((const uint2*)((const bf16_t*)Y + (size_t)row_ * D))[lane + 64 * j]; { const f32x4 t_ = __builtin_nontemporal_load((const f32x4*)(x + (size_t)row_ * D) + lane + 64 * j); RX[rr][j] = make_float4(t_[0], t_[1], t_[2], t_[3]); } } } \
            asm volatile("" ::: "memory"); } while (0)
#define ROUTE_PASS(RX, RY, p, NEXT) do { \
            _Pragma("unroll") for (int rr = 0; rr < 2; ++rr) { \
                const int rowl = 2 * wave + rr, row = 128 * bx + 16 * (p) + rowl; \
                float4 yv[4], xv[4]; float ss = 0.f; \
                _Pragma("unroll") for (int j = 0; j < 4; ++j) { const uint2 yr = RY[rr][j]; yv[j] = make_float4(bf2f(yr.x & 0xffffu), bf2f(yr.x >> 16), bf2f(yr.y & 0xffffu), bf2f(yr.y >> 16)); xv[j] = RX[rr][j]; \
                    ss += yv[j].x * yv[j].x + yv[j].y * yv[j].y + yv[j].z * yv[j].z + yv[j].w * yv[j].w; } \
                const float rstd_y = rsqrtf(wave_sum(ss) * (1.f / D) + EPS); \
                float s1 = 0.f; \
                _Pragma("unroll") for (int j = 0; j < 4; ++j) { const int col = 4 * lane + 256 * j; const f32x4 pa = *(LAS const f32x4*)(PA + col); \
                    xv[j].x += pa[0] * yv[j].x * rstd_y; xv[j].y += pa[1] * yv[j].y * rstd_y; xv[j].z += pa[2] * yv[j].z * rstd_y; xv[j].w += pa[3] * yv[j].w * rstd_y; \
                    { uint2 xw_; xw_.x = pk2(xv[j].x, xv[j].y); xw_.y = pk2(xv[j].z, xv[j].w); ((uint2*)(X1B + (size_t)row * D))[lane + 64 * j] = xw_; } \
                    s1 += xv[j].x * xv[j].x + xv[j].y * xv[j].y + xv[j].z * xv[j].z + xv[j].w * xv[j].w; } \
                const float rstd1 = rsqrtf(wave_sum(s1) * (1.f / D) + EPS); \
                _Pragma("unroll") for (int j = 0; j < 4; ++j) { const int col = 4 * lane + 256 * j; const f32x4 pb = *(LAS const f32x4*)(PB + col), pc = *(LAS const f32x4*)(PC + col); \
                    f32x4 hv; \
                    hv[0] = xv[j].x * rstd1 * pb[0] + pc[0]; hv[1] = xv[j].y * rstd1 * pb[1] + pc[1]; \
                    hv[2] = xv[j].z * rstd1 * pb[2] + pc[2]; hv[3] = xv[j].w * rstd1 * pb[3] + pc[3]; \
                    *(unsigned*)(H2F + (size_t)row * D + col) = pk4_fp8(hv[0], hv[1], hv[2], hv[3]); \
                    { const xu32x2 wh = (xu32x2){pk_hi(hv[0], hv[1]), pk_hi(hv[2], hv[3])}, wl = (xu32x2){pk_lo(hv[0], hv[1]), pk_lo(hv[2], hv[3])}; \
                      *(LAS xu32x2*)(HTH + rowl * HTB + col * 2) = wh; *(LAS xu32x2*)(HTL + rowl * HTB + col * 2) = wl; } } \
            } \
            NEXT;                                                   \
            __syncthreads(); \
            { f32x4 a0 = (f32x4){0.f, 0.f, 0.f, 0.f}, a1 = (f32x4){0.f, 0.f, 0.f, 0.f}; \
              xbf16x8 ah[4], al[4]; \
              _Pragma("unroll") for (int s = 0; s < 4; ++s) { ah[s] = *(LAS const xbf16x8*)(HTH + fr * HTB + (128 * wave + 32 * s + 8 * fq) * 2); al[s] = *(LAS const xbf16x8*)(HTL + fr * HTB + (128 * wave + 32 * s + 8 * fq) * 2); } \
              asm volatile("s_waitcnt lgkmcnt(0)" ::: "memory"); __builtin_amdgcn_sched_barrier(0);     \
              _Pragma("unroll") for (int s = 0; s < 4; ++s) { \
                  a0 = __builtin_amdgcn_mfma_f32_16x16x32_bf16(ah[s], bh[s][0], a0, 0, 0, 0); a1 = __builtin_amdgcn_mfma_f32_16x16x32_bf16(ah[s], bh[s][1], a1, 0, 0, 0); \
                  a0 = __builtin_amdgcn_mfma_f32_16x16x32_bf16(ah[s], bl[s][0], a0, 0, 0, 0); a1 = __builtin_amdgcn_mfma_f32_16x16x32_bf16(ah[s], bl[s][1], a1, 0, 0, 0); \
                  a0 = __builtin_amdgcn_mfma_f32_16x16x32_bf16(al[s], bh[s][0], a0, 0, 0, 0); a1 = __builtin_amdgcn_mfma_f32_16x16x32_bf16(al[s], bh[s][1], a1, 0, 0, 0); } \
              _Pragma("unroll") for (int r = 0; r < 4; ++r) { PART[(wave * 16 + 4 * fq + r) * 32 + fr] = a0[r]; PART[(wave * 16 + 4 * fq + r) * 32 + 16 + fr] = a1[r]; } } \
            __syncthreads(); \
            { const int rr = lane >> 5, e = lane & 31, rowl = 2 * wave + rr, row = 128 * bx + 16 * (p) + rowl; \
              float mine = b_router[e]; \
              _Pragma("unroll") for (int w2 = 0; w2 < 8; ++w2) mine += PART[(w2 * 16 + rowl) * 32 + e]; \
              float my_v = -INFINITY, v0 = 0.f; int my_e = 0; \
              _Pragma("unroll") for (int r = 0; r < 4; ++r) { float bv = mine; int bi = e; \
                  ARGMAX_DPP(0xB1, bv, bi); ARGMAX_DPP(0x4E, bv, bi); ARGMAX_DPP(0x141, bv, bi); ARGMAX_DPP(0x140, bv, bi); \
                  { const float ov = __shfl_xor(bv, 16); const int oi = __shfl_xor(bi, 16); if (ov > bv || (ov == bv && oi < bi)) { bv = ov; bi = oi; } } \
                  if (r == 0) v0 = bv; \
                  if (e == r) { my_v = bv; my_e = bi; } \
                  if (e == bi) mine = -INFINITY; } \
              const float ex = e < 4 ? __expf(my_v - v0) : 0.f; \
              float gs = ex; gs += dpp_mov_f<0xB1>(gs); gs += dpp_mov_f<0x4E>(gs); \
              if (e < 4) { const int rk = __hip_atomic_fetch_add(lcnt + my_e, 1, __ATOMIC_RELAXED, __HIP_MEMORY_SCOPE_WORKGROUP); \
                  TOPG[row * 4 + e] = ex / gs; er_l[(16 * (p) + rowl) * 4 + e] = my_e | (rk << 8); } } \
        } while (0)
        { float4 xA[2][4]; uint2 yA[2][4];
#pragma unroll 1
          ROUTE_LOAD(xA, yA, 0);
          for (int p = 0; p < 8; ++p) { ROUTE_PASS(xA, yA, p, { const int pn_ = p < 7 ? p + 1 : p; ROUTE_LOAD(xA, yA, pn_); }); } }
#undef ROUTE_LOAD
#undef ROUTE_PASS
        __syncthreads();
        if (tid < 32) lbase[tid] = atomicAdd(ctl + CW_CNT + tid, lcnt[tid]);
        __syncthreads();
        { int t1 = tid; asm volatile("" : "+v"(t1)); const int v = er_l[t1], e = v & 255, pos = lbase[e] + (v >> 8), i = bx * NTHR + tid;
          SLOTE[(size_t)e * M + pos] = i >> 2; TPOS[i] = (e << 16) | pos; }
    }
    SEAM(PH_ROUTE);
#define EXPERT_TABLES(WITH_TE, HAVE)   \
        LAS int* te_l = (LAS int*)(lds + LDSCTL_OFF + 1024); LAS int* tb_l = (LAS int*)(lds + LDSCTL_OFF + 6144); LAS int* cn_l = tb_l + 64; \
        if (!(HAVE) && wave == 0) { const int c_ = lane < NE ? __hip_atomic_load(ctl + CW_CNT + (lane & 31), __ATOMIC_RELAXED, __HIP_MEMORY_SCOPE_AGENT) : 0; const int t_ = (c_ + 255) >> 8; int in_ = t_; \
            _Pragma("unroll") for (int o_ = 1; o_ < 32; o_ <<= 1) { const int u_ = __shfl_up(in_, o_); if (lane >= o_) in_ += u_; } \
            if (lane < NE) { cn_l[lane] = c_; tb_l[lane] = in_ - t_; } if (lane == NE - 1) tb_l[NE] = in_; } \
        __syncthreads(); \
        const int ntiles = __builtin_amdgcn_readfirstlane(tb_l[NE]); \
        if (WITH_TE && !(HAVE)) { int t0 = tid; asm volatile("" : "+v"(t0));          \
          for (int t = t0; t < ntiles; t += NTHR) { int e_ = 0; _Pragma("unroll") for (int k_ = 1; k_ < NE; ++k_) e_ = tb_l[k_] <= t ? k_ : e_; te_l[t] = e_; } \
          __syncthreads(); }
    if (IN(PH_E1)) {
        EXPERT_TABLES(true, false)
        pg8::Gemm g{XN, W1T, 1024, (size_t)2048 * 1024, (const int*)(ws + WS_SLOTE), tb_l, cn_l}; pg8::Order O; O.init(ntiles, 8, G, bx, te_l);
        pg8::EpiE1 E{(unsigned char*)ACT, args.in[17], args.in[18], (unsigned char*)W2T, gw};
        pg8::gemm_phase<pg8::EpiE1, 1, true>(lds, g, O, E);
    }
    SEAM(PH_E1);
    if (IN(PH_E2)) {
        EXPERT_TABLES(true, IN(PH_E1))
        pg8::Gemm g{ACT, W2T, 1024, (size_t)1024 * 1024, nullptr, nullptr, nullptr}; pg8::Order O; O.init(ntiles, 4, G, bx, te_l);
        pg8::EpiE2 E{(unsigned char*)YS, args.in[19]};
        pg8::gemm_phase<pg8::EpiE2, 2, true>(lds, g, O, E);
    }
    SEAM(PH_E2);
    if (IN(PH_FINAL)) {
        typedef float f32x4 __attribute__((ext_vector_type(4)));
        const float* g_mpost = args.in[13]; float* outp = args.out;
        LAS float* PM = (LAS float*)lds;
        { int c0 = tid; asm volatile("" : "+v"(c0));
          for (int c = c0; c < 4096; c += NTHR) PM[c] = MODV(c >> 10, 5120 + (c & 1023)) * g_mpost[c & 1023]; }
        EXPERT_TABLES(false, IN(PH_E1) || IN(PH_E2))
        int row = gw;
        int pos_n[4]; float g_n[4];
#pragma unroll
        for (int k = 0; k < 4; ++k) { pos_n[k] = TPOS[row * 4 + k]; g_n[k] = TOPG[row * 4 + k]; }
#pragma unroll 1
        for (; row < M; row += NGW) {
            const int b = row / S;
            unsigned raw[4][4]; float4 o[4]; float gk[4];
#pragma unroll
            for (int k = 0; k < 4; ++k) { gk[k] = g_n[k]; const int pp = tb_l[pos_n[k] >> 16] * 256 + (pos_n[k] & 0xffff);
#pragma unroll
                for (int j = 0; j < 4; ++j) raw[k][j] = __builtin_nontemporal_load((const unsigned*)((const unsigned char*)YS + (size_t)pp * 1024 + 4 * lane + 256 * j)); }
#pragma unroll
            for (int j = 0; j < 4; ++j) { const uint2 xr_ = __builtin_bit_cast(uint2, __builtin_nontemporal_load((const unsigned long long*)((const bf16_t*)(ws + WS_X1B) + (size_t)row * D) + lane + 64 * j)); o[j] = make_float4(bf2f(xr_.x & 0xffffu), bf2f(xr_.x >> 16), bf2f(xr_.y & 0xffffu), bf2f(xr_.y >> 16)); }
            { const int rn = row + NGW < M ? row + NGW : row;
#pragma unroll
              for (int k = 0; k < 4; ++k) { pos_n[k] = TPOS[rn * 4 + k]; g_n[k] = TOPG[rn * 4 + k]; } }
            asm volatile("" ::: "memory");
            float y[16];
#pragma unroll
            for (int i = 0; i < 16; ++i) y[i] = 0.f;
#pragma unroll
            for (int k = 0; k < 4; ++k)
#pragma unroll
                for (int j = 0; j < 4; ++j) { const fp8x2_f32 lo2 = __builtin_amdgcn_cvt_pk_f32_fp8((int)raw[k][j], false), hi2 = __builtin_amdgcn_cvt_pk_f32_fp8((int)raw[k][j], true);
                    y[j * 4 + 0] += gk[k] * lo2[0]; y[j * 4 + 1] += gk[k] * lo2[1]; y[j * 4 + 2] += gk[k] * hi2[0]; y[j * 4 + 3] += gk[k] * hi2[1]; }
            float ss = 0.f;
#pragma unroll
            for (int i = 0; i < 16; ++i) ss += y[i] * y[i];
            const float rstd = rsqrtf(wave_sum(ss) * (1.f / D) + EPS);
#pragma unroll
            for (int j = 0; j < 4; ++j) { const int col = 4 * lane + 256 * j; const f32x4 pm = *(LAS const f32x4*)(PM + b * 1024 + col);
                float4 ov = o[j];
                ov.x += pm[0] * y[j * 4 + 0] * rstd; ov.y += pm[1] * y[j * 4 + 1] * rstd; ov.z += pm[2] * y[j * 4 + 2] * rstd; ov.w += pm[3] * y[j * 4 + 3] * rstd;
                ((float4*)(outp + (size_t)row * D))[lane + 64 * j] = ov; }
        }
    }
#undef IN
#undef SEAM
}

static void launch_mk(const Args& a0, int lo, int hi, hipStream_t stream) {
    Args a = a0; a.ph_lo = lo; a.ph_hi = hi;
    hipLaunchKernelGGL(mk_fwd, dim3(256), dim3(NTHR), LDS_BYTES, stream, a);
}
extern "C" void kernel_launch(void* const* d_in, const int* in_sizes, int n_in, void* d_out, int out_size, void* d_ws, size_t ws_size, hipStream_t stream) {
    if (n_in != 20 || out_size != M * D || ws_size < WS_END2) { fprintf(stderr, "kernel_launch: unexpected shapes (n_in %d out %d ws %zu need %zu)\n", n_in, out_size, ws_size, (size_t)WS_END2); return; }
    static bool attr_set = false;
    if (!attr_set) { (void)hipFuncSetAttribute((const void*)mk_fwd, hipFuncAttributeMaxDynamicSharedMemorySize, LDS_BYTES); attr_set = true; }
    const float* x = (const float*)d_in[0];
    const float* g_apost = (const float*)d_in[5]; const float* w_gk2 = (const float*)d_in[7];
    const float* b_gk = (const float*)d_in[8]; const float* gla_gain = (const float*)d_in[9]; const float* b_f = (const float*)d_in[10];
    const float* g_mpre = (const float*)d_in[12]; const float* g_mpost = (const float*)d_in[13]; const float* w_router = (const float*)d_in[14]; const float* b_router = (const float*)d_in[15];
    float* out = (float*)d_out; unsigned char* ws = (unsigned char*)d_ws;
    int* ctl = (int*)(ws + WS_CTL); float* mod = (float*)(ws + WS_MOD); float* ZF = (float*)(ws + WS_ZF); float* NF = (float*)(ws + WS_NF);
    int* TOPE = (int*)(ws + WS_TOPE); float* TOPG = (float*)(ws + WS_TOPG); int* RANK = (int*)(ws + WS_RANK); int* TPOS = (int*)(ws + WS_TPOS); int* SLOT = (int*)(ws + WS_SLOT);
    bf16_t* XN = (bf16_t*)(ws + WS_XN); bf16_t* PROJ = (bf16_t*)(ws + WS_PROJ); bf16_t* AO = (bf16_t*)(ws + WS_AO); float* Y = (float*)(ws + WS_Y);
    bf16_t* YS = (bf16_t*)(ws + WS_YS);
    Args a{}; for (int i = 0; i < 20; ++i) a.in[i] = (const float*)d_in[i]; a.out = out; a.ws = ws;
    (void)hipMemsetAsync(ws + WS_CTL, 0, 32768, stream);
    launch_mk(a, 0, PH_COUNT, stream);
}
```
